# Optimizing an MI355X kernel written in HIP

```python
import jax, jax.numpy as jnp
from jax import lax
import numpy as np

D_MODEL = 2048
BATCH = 4
SEQ = 4096
DEPTH = 1

N_ATTN_HEADS = 8
HEAD_DIM = 128
ATTN_WIDTH = N_ATTN_HEADS * HEAD_DIM
POOL_WIDTH = D_MODEL - ATTN_WIDTH
POOL_WINDOWS = (2, 4, 8, 16)
N_POOL_GROUPS = len(POOL_WINDOWS)
POOL_GROUP_DIM = POOL_WIDTH // N_POOL_GROUPS
MIX_WIDTH = ATTN_WIDTH + POOL_WIDTH
IN_PROJ_WIDTH = 3 * ATTN_WIDTH + POOL_WIDTH
MOBA_BLOCK = 256
MOBA_TOPK = 3
Q_CHUNK = 32
ROT_DIM = HEAD_DIM // 4
ROPE_THETA = 500000.0
D_FF = 5632
EPS = 1e-6
NEG_INF = -1e30
MAX_POS_OFFSET = 1024

kernel_name = "hymba_moba_pool_macaron_layer"


def rmsnorm(x, gain):
    xf = x.astype(jnp.float32)
    inv = lax.rsqrt(jnp.mean(xf * xf, axis=-1, keepdims=True) + EPS)
    return (xf * inv * gain.astype(jnp.float32)).astype(x.dtype)


def swiglu(h, w_gate, w_up, w_down):
    return (jax.nn.silu(h @ w_gate) * (h @ w_up)) @ w_down


def partial_rope(x, positions):
    inv_freq = ROPE_THETA ** (-jnp.arange(0, ROT_DIM, 2, dtype=jnp.float32) / ROT_DIM)
    ang = positions.astype(jnp.float32)[:, None, :, None] * inv_freq
    cos, sin = jnp.cos(ang), jnp.sin(ang)
    xr = x[..., :ROT_DIM].astype(jnp.float32)
    x1, x2 = xr[..., :ROT_DIM // 2], xr[..., ROT_DIM // 2:]
    rot = jnp.concatenate([x1 * cos - x2 * sin, x2 * cos + x1 * sin], axis=-1).astype(x.dtype)
    return jnp.concatenate([rot, x[..., ROT_DIM:]], axis=-1)


def moba_attention(q, k, v):
    B, H, S, Dh = q.shape
    nb = -(-S // MOBA_BLOCK)
    s_pad = nb * MOBA_BLOCK
    pad = ((0, 0), (0, 0), (0, s_pad - S), (0, 0))
    kb = jnp.pad(k, pad).reshape(B, H, nb, MOBA_BLOCK, Dh)
    vb = jnp.pad(v, pad).reshape(B, H, nb, MOBA_BLOCK, Dh)
    k_mean = jnp.mean(kb.astype(jnp.float32), axis=3)
    topk = min(MOBA_TOPK, nb)
    scale = HEAD_DIM ** -0.5
    n_chunks = S // Q_CHUNK
    q_chunks = q.reshape(B, H, n_chunks, Q_CHUNK, Dh).transpose(2, 0, 1, 3, 4)
    b_idx = jnp.arange(B)[:, None, None, None]
    h_idx = jnp.arange(H)[None, :, None, None]
    block_ids = jnp.arange(nb)

    def chunk_attn(args):
        c, qc = args
        q_start = c * Q_CHUNK
        qblk = q_start // MOBA_BLOCK
        gate = jnp.einsum('bhqd,bhnd->bhqn', qc.astype(jnp.float32), k_mean)
        gate = jnp.where(block_ids < qblk, gate, NEG_INF)
        _, sel = lax.top_k(gate, topk)
        sel_valid = sel < qblk
        k_sel = kb[b_idx, h_idx, sel]
        v_sel = vb[b_idx, h_idx, sel]
        s_sel = jnp.einsum('bhqd,bhqjpd->bhqjp', qc, k_sel).astype(jnp.float32) * scale
        s_sel = jnp.where(sel_valid[..., None], s_sel, NEG_INF).reshape(B, H, Q_CHUNK, topk * MOBA_BLOCK)
        k_own = lax.dynamic_index_in_dim(kb, qblk, axis=2, keepdims=False)
        v_own = lax.dynamic_index_in_dim(vb, qblk, axis=2, keepdims=False)
        s_own = jnp.einsum('bhqd,bhpd->bhqp', qc, k_own).astype(jnp.float32) * scale
        q_pos = q_start + jnp.arange(Q_CHUNK)
        k_pos = qblk * MOBA_BLOCK + jnp.arange(MOBA_BLOCK)
        s_own = jnp.where(k_pos[None, :] <= q_pos[:, None], s_own, NEG_INF)
        p = jax.nn.softmax(jnp.concatenate([s_sel, s_own], axis=-1), axis=-1)
        p_sel = p[..., :topk * MOBA_BLOCK].reshape(B, H, Q_CHUNK, topk, MOBA_BLOCK).astype(v.dtype)
        p_own = p[..., topk * MOBA_BLOCK:].astype(v.dtype)
        return (jnp.einsum('bhqjp,bhqjpd->bhqd', p_sel, v_sel)
                + jnp.einsum('bhqp,bhpd->bhqd', p_own, v_own))

    out = lax.map(chunk_attn, (jnp.arange(n_chunks), q_chunks))
    return out.transpose(1, 2, 0, 3, 4).reshape(B, H, S, Dh)


def multiscale_pool(u, pool_w, pool_scale):
    B, S, _ = u.shape
    ug = u.reshape(B, S, N_POOL_GROUPS, POOL_GROUP_DIM).astype(jnp.float32)
    csum = jnp.pad(jnp.cumsum(ug, axis=1), ((0, 0), (1, 0), (0, 0), (0, 0)))
    t = jnp.arange(S)
    windows = jnp.array(POOL_WINDOWS, dtype=jnp.int32)
    start = jnp.maximum(t[:, None] + 1 - windows[None, :], 0)
    count = (t[:, None] + 1 - start).astype(jnp.float32)
    g_idx = jnp.arange(N_POOL_GROUPS)[None, :]
    window_sum = csum[:, 1:] - csum[:, start, g_idx]
    pooled = (window_sum / count[None, :, :, None] - ug).astype(u.dtype)
    y = jnp.einsum('bsgc,gcd->bsgd', pooled, pool_w).reshape(B, S, POOL_WIDTH)
    return y * pool_scale


def setup_inputs(seed: int = 0) -> dict:
    key = jax.random.key(seed)
    ks = jax.random.split(key, 20)
    f32 = jnp.float32

    def normal(k, shape, fan_in):
        return jax.random.normal(k, shape, f32) * (fan_in ** -0.5)

    def gain(k, shape):
        return 1.0 + 0.02 * jax.random.normal(k, shape, f32)

    x = jax.random.normal(ks[0], (BATCH, SEQ, D_MODEL), f32)
    offsets = jax.random.randint(ks[1], (BATCH, 1), 0, MAX_POS_OFFSET, dtype=jnp.int32)
    positions = (jnp.arange(SEQ, dtype=jnp.int32)[None, :] + offsets).astype(jnp.int32)
    return {
        "x": x,
        "positions": positions,
        "norm_ffn1": gain(ks[2], (DEPTH, D_MODEL)),
        "w1_gate": normal(ks[3], (DEPTH, D_MODEL, D_FF), D_MODEL),
        "w1_up": normal(ks[4], (DEPTH, D_MODEL, D_FF), D_MODEL),
        "w1_down": normal(ks[5], (DEPTH, D_FF, D_MODEL), D_FF),
        "norm_mix": gain(ks[6], (DEPTH, D_MODEL)),
        "w_in": normal(ks[7], (DEPTH, D_MODEL, IN_PROJ_WIDTH), D_MODEL),
        "pool_w": normal(ks[8], (DEPTH, N_POOL_GROUPS, POOL_GROUP_DIM, POOL_GROUP_DIM), POOL_GROUP_DIM),
        "pool_scale": 1.0 + 0.1 * jax.random.normal(ks[9], (DEPTH, POOL_WIDTH), f32),
        "w_out": normal(ks[10], (DEPTH, MIX_WIDTH, D_MODEL), MIX_WIDTH),
        "norm_ffn2": gain(ks[11], (DEPTH, D_MODEL)),
        "w2_gate": normal(ks[12], (DEPTH, D_MODEL, D_FF), D_MODEL),
        "w2_up": normal(ks[13], (DEPTH, D_MODEL, D_FF), D_MODEL),
        "w2_down": normal(ks[14], (DEPTH, D_FF, D_MODEL), D_FF),
        "norm_final": gain(ks[15], (D_MODEL,)),
    }


def reference(x, positions, norm_ffn1, w1_gate, w1_up, w1_down, norm_mix, w_in, pool_w,
              pool_scale, w_out, norm_ffn2, w2_gate, w2_up, w2_down, norm_final):
    B, S, _ = x.shape
    for l in range(DEPTH):
        x = x + 0.5 * swiglu(rmsnorm(x, norm_ffn1[l]), w1_gate[l], w1_up[l], w1_down[l])
        h = rmsnorm(x, norm_mix[l])
        proj = h @ w_in[l]
        q, k, v, u = jnp.split(proj, [ATTN_WIDTH, 2 * ATTN_WIDTH, 3 * ATTN_WIDTH], axis=-1)
        to_heads = lambda t: t.reshape(B, S, N_ATTN_HEADS, HEAD_DIM).transpose(0, 2, 1, 3)
        q = partial_rope(to_heads(q), positions)
        k = partial_rope(to_heads(k), positions)
        attn = moba_attention(q, k, to_heads(v))
        attn = attn.transpose(0, 2, 1, 3).reshape(B, S, ATTN_WIDTH)
        pooled = multiscale_pool(u, pool_w[l], pool_scale[l])
        x = x + jnp.concatenate([attn, pooled], axis=-1) @ w_out[l]
        x = x + 0.5 * swiglu(rmsnorm(x, norm_ffn2[l]), w2_gate[l], w2_up[l], w2_down[l])
    return rmsnorm(x, norm_final)
```

```cpp
#include <hip/hip_runtime.h>
#include <hip/hip_cooperative_groups.h>
#include <cstdio>
#include <cstdint>
namespace cg = cooperative_groups;
#ifndef REP_P0
#define REP_P0 1
#endif
#ifndef REP_P1
#define REP_P1 1
#endif
#ifndef REP_ATT
#define REP_ATT 1
#endif

#define LAS __attribute__((address_space(3)))
typedef unsigned short bf16_t;
typedef short bf16x8 __attribute__((ext_vector_type(8)));
typedef float f32x4 __attribute__((ext_vector_type(4)));
typedef float f32x16 __attribute__((ext_vector_type(16)));
typedef unsigned u32x4 __attribute__((ext_vector_type(4)));
typedef unsigned u32x2 __attribute__((ext_vector_type(2)));

constexpr int M = 16384, SEQ = 4096, D = 2048, FF = 5632, AW = 1024, NH = 8, HD = 128;
constexpr int NQKU = 3072;
constexpr float EPS = 1e-6f;
constexpr float NEGBIG = -1e30f;
constexpr float QSCALE = 0.08838834764831845f * 1.4426950408889634f;

__device__ __forceinline__ unsigned cvt_pk_bf16(float lo, float hi) { unsigned r; asm volatile("v_cvt_pk_bf16_f32 %0, %1, %2" : "=v"(r) : "v"(lo), "v"(hi)); return r; }
__device__ __forceinline__ float bf2f(unsigned short b) { return __builtin_bit_cast(float, (unsigned)b << 16); }

namespace pg8 {
constexpr int BM = 256, BK = 64, HALF = 128, HTB = HALF * BK * 2, STAGE_BYTES = 8 * HTB, NXCD = 8, WGM = 8;
__host__ __device__ __forceinline__ int lds_byte(int r, int c) { const int st = (r >> 4) * 2 + (c >> 5), rr = r & 15, cc = c & 31, ob = rr * 64 + cc * 2; return st * 1024 + (ob ^ (((ob >> 9) & 1) << 5)); }
__host__ __device__ __forceinline__ void stage_rc(int b, int& R, int& C) { const int st = b / 1024, sb = b % 1024, swz = sb ^ (((sb >> 9) & 1) << 5); R = (st >> 1) * 16 + swz / 64; C = (st & 1) * 32 + (swz % 64) / 2; }
__host__ __device__ __forceinline__ int perm32(int rho) { const int n = rho >> 4, i = rho & 15; return 8 * (i >> 2) + 4 * n + (i & 3); }

struct Unit { int pm, pn; };
struct Gemm { const bf16_t* A; const bf16_t* Bt; int M, N, K; };

struct StaticOrder {
    int nM, nN, nwg, G, c;
    __device__ void init(int M_, int N_, int G_, int c_) { nM = M_ / BM; nN = N_ / BM; nwg = nM * nN; G = G_; c = c_; }
    __device__ bool next(int i, Unit& u) const {
        const long L = (long)i * G + c; if (L >= nwg) return false;
        int wgid = (int)L; { const int q = nwg / NXCD, r = nwg % NXCD, xcd = wgid % NXCD, off = wgid / NXCD; wgid = (xcd < r ? xcd * (q + 1) : r * (q + 1) + (xcd - r) * q) + off; }
        const int nig = WGM * nN, gid = wgid / nig, fm = gid * WGM, gsz = (nM - fm) < WGM ? (nM - fm) : WGM;
        u.pm = fm + ((wgid % nig) % gsz); u.pn = (wgid % nig) / gsz; return true;
    }
    __device__ __forceinline__ void a_ready(const Unit&) const {}
    __device__ __forceinline__ void done(const Unit&) const {}
};
struct OneUnit {
    Unit u0;
    __device__ bool next(int i, Unit& u) const { if (i > 0) return false; u = u0; return true; }
    __device__ __forceinline__ void a_ready(const Unit&) const {}
    __device__ __forceinline__ void done(const Unit&) const {}
};

template <class Epi, class Sched, bool ALIGN_EPI = false, bool SP2 = false>
__device__ __forceinline__ void gemm_phase(LAS unsigned char* lds, const Gemm g, const Sched& S, const Epi& E) {
    int tid = threadIdx.x; asm volatile("" : "+v"(tid));
    const int wid = __builtin_amdgcn_readfirstlane(tid >> 6), lane = tid & 63, wr = wid >> 2, wc = wid & 3, fr = lane & 15, fq = lane >> 4;
    const int K = g.K, nt = K / BK;
    unsigned voffA[2], voffB[2];
#pragma unroll
    for (int i = 0; i < 2; ++i) { int R, C; stage_rc(tid * 16 + i * 8192, R, C); const int Rb = Epi::PERM ? ((R & ~31) + perm32(R & 31)) : R;
        voffA[i] = (unsigned)(R * K + C) * 2u; voffB[i] = (unsigned)(Rb * K + C) * 2u; }
    const size_t kstep = (size_t)(BK * 2);
    const size_t hstep = (size_t)HALF * K * 2;
    const size_t tstep = 2 * hstep;
    const unsigned ldsw = (unsigned)wid * 1024u;
    const int aoff = lds_byte(wr * 64 + fr, fq * 8), boff = lds_byte(wc * 32 + fr, fq * 8);
#define PG8_SA(b, h) (((b) * 2 + (h)) * HTB)
#define PG8_SB(b, h) ((4 + (b) * 2 + (h)) * HTB)
#define PG8_STAGE(bufoff, gbase, voff) do { _Pragma("unroll") for (int _i = 0; _i < 2; ++_i) \
        __builtin_amdgcn_global_load_lds((const unsigned*)((const char*)(gbase) + (voff)[_i]), (LAS unsigned*)(lds + (bufoff) + ldsw + _i * 8192), 16, 0, 0); } while (0)
#define PG8_LDA(dst, b, h) do { _Pragma("unroll") for (int m = 0; m < 4; ++m) _Pragma("unroll") for (int k = 0; k < 2; ++k) dst[m][k] = *(const LAS bf16x8*)(lds + PG8_SA(b, h) + aoff + m * 2048 + k * 1024); } while (0)
#define PG8_LDB(dst, b, h) do { _Pragma("unroll") for (int n = 0; n < 2; ++n) _Pragma("unroll") for (int k = 0; k < 2; ++k) dst[n][k] = *(const LAS bf16x8*)(lds + PG8_SB(b, h) + boff + n * 2048 + k * 1024); } while (0)
#define PG8_MMA(ai, bj, At, Bt) do { __builtin_amdgcn_s_setprio(1); _Pragma("unroll") for (int m = 0; m < 4; ++m) _Pragma("unroll") for (int n = 0; n < 2; ++n) _Pragma("unroll") for (int k = 0; k < 2; ++k) \
        acc[ai][bj][m][n] = __builtin_amdgcn_mfma_f32_16x16x32_bf16(Bt[n][k], At[m][k], acc[ai][bj][m][n], 0, 0, 0); __builtin_amdgcn_s_setprio(0); } while (0)
#define PG8_WAIT_V(n) asm volatile("s_waitcnt vmcnt(" #n ")" ::: "memory")
#define PG8_WAIT_L(n) asm volatile("s_waitcnt lgkmcnt(" #n ")" ::: "memory")
#define PG8_BAR __builtin_amdgcn_s_barrier()
#define PG8_SCHED __builtin_amdgcn_sched_barrier(0)
    Unit cur, nxt; int ui = 0;
    if (!S.next(0, cur)) return;
    typename Epi::Pre pre_cur = E.pre(cur, wr, fr), pre_nxt = pre_cur;
    f32x4 acc[2][2][4][2];
#pragma unroll
    for (int a = 0; a < 2; ++a)
#pragma unroll
        for (int b = 0; b < 2; ++b)
#pragma unroll
            for (int m = 0; m < 4; ++m)
#pragma unroll
                for (int n = 0; n < 2; ++n) acc[a][b][m][n] = (f32x4){0.f, 0.f, 0.f, 0.f};
    bf16x8 At[4][2], B0[2][2], B1[2][2];
    const char* cA = (const char*)g.A + (size_t)cur.pm * tstep; const char* cB = (const char*)g.Bt + (size_t)cur.pn * tstep;
    S.a_ready(cur);
    if constexpr (SP2) {
        PG8_STAGE(PG8_SB(0, 0), cB, voffB); PG8_STAGE(PG8_SB(0, 1), cB + hstep, voffB); PG8_STAGE(PG8_SA(0, 0), cA, voffA); PG8_STAGE(PG8_SA(0, 1), cA + hstep, voffA);
        if (wr == 1) PG8_BAR;
        PG8_WAIT_V(2); PG8_BAR;
        PG8_STAGE(PG8_SB(1, 0), cB + kstep, voffB); PG8_STAGE(PG8_SA(1, 0), cA + kstep, voffA); PG8_STAGE(PG8_SB(1, 1), cB + hstep + kstep, voffB);
        PG8_WAIT_V(6); PG8_BAR;
    } else {
        PG8_STAGE(PG8_SB(0, 0), cB, voffB); PG8_STAGE(PG8_SA(0, 0), cA, voffA); PG8_STAGE(PG8_SB(0, 1), cB + hstep, voffB); PG8_STAGE(PG8_SA(0, 1), cA + hstep, voffA);
        if (wr == 1) PG8_BAR;
        PG8_WAIT_V(4); PG8_BAR;
        PG8_STAGE(PG8_SB(1, 0), cB + kstep, voffB); PG8_STAGE(PG8_SA(1, 0), cA + kstep, voffA); PG8_STAGE(PG8_SB(1, 1), cB + hstep + kstep, voffB);
        PG8_WAIT_V(6); PG8_BAR;
    }
    for (;;) {
        const bool has_next = S.next(ui + 1, nxt);
        const char* nA = has_next ? (const char*)g.A + (size_t)nxt.pm * tstep : cA; const char* nB = has_next ? (const char*)g.Bt + (size_t)nxt.pn * tstep : cB;
        for (int t = 0; t < nt; t += 2) {
            const bool last = (t == nt - 2);
            const char* a1 = cA + (size_t)(t + 1) * kstep;
            const char* a2 = last ? nA : cA + (size_t)(t + 2) * kstep; const char* b2 = last ? nB : cB + (size_t)(t + 2) * kstep;
            const char* a3 = a2 + kstep; const char* b3 = b2 + kstep;
            if (last && has_next) { S.a_ready(nxt); pre_nxt = E.pre(nxt, wr, fr); }
            if constexpr (SP2) {
            PG8_LDB(B0, 0, 0); PG8_LDB(B1, 0, 1); PG8_SCHED; PG8_LDA(At, 0, 0); PG8_STAGE(PG8_SA(1, 1), a1 + hstep, voffA);
            PG8_WAIT_V(8); PG8_WAIT_L(0); PG8_BAR; PG8_MMA(0, 0, At, B0); PG8_MMA(0, 1, At, B1); PG8_BAR; PG8_SCHED;
            PG8_LDA(At, 0, 1); PG8_STAGE(PG8_SB(0, 0), b2, voffB); PG8_STAGE(PG8_SB(0, 1), b2 + hstep, voffB); PG8_STAGE(PG8_SA(0, 0), a2, voffA);
            PG8_WAIT_V(8); PG8_WAIT_L(0); PG8_BAR; PG8_MMA(1, 0, At, B0); PG8_MMA(1, 1, At, B1); PG8_BAR; PG8_SCHED;
            PG8_LDB(B0, 1, 0); PG8_LDB(B1, 1, 1); PG8_SCHED; PG8_LDA(At, 1, 0); PG8_STAGE(PG8_SA(0, 1), a2 + hstep, voffA);
            PG8_WAIT_V(8); PG8_WAIT_L(0); PG8_BAR; PG8_MMA(0, 0, At, B0); PG8_MMA(0, 1, At, B1); PG8_BAR; PG8_SCHED;
            PG8_LDA(At, 1, 1); PG8_STAGE(PG8_SB(1, 0), b3, voffB); PG8_STAGE(PG8_SB(1, 1), b3 + hstep, voffB); PG8_STAGE(PG8_SA(1, 0), a3, voffA);
            PG8_WAIT_V(8); PG8_WAIT_L(0); PG8_BAR; PG8_MMA(1, 0, At, B0); PG8_MMA(1, 1, At, B1); PG8_BAR; PG8_SCHED;
            } else {
            PG8_LDB(B0, 0, 0); PG8_SCHED; PG8_LDA(At, 0, 0); PG8_STAGE(PG8_SA(1, 1), a1 + hstep, voffA);
            PG8_WAIT_L(8); PG8_BAR; PG8_WAIT_L(0); PG8_MMA(0, 0, At, B0); PG8_BAR; PG8_SCHED;
            PG8_LDB(B1, 0, 1); PG8_STAGE(PG8_SB(0, 0), b2, voffB);
            PG8_BAR; PG8_WAIT_L(0); PG8_MMA(0, 1, At, B1); PG8_BAR;
            PG8_LDA(At, 0, 1); PG8_STAGE(PG8_SA(0, 0), a2, voffA);
            PG8_BAR; PG8_WAIT_L(0); PG8_MMA(1, 0, At, B0); PG8_BAR; PG8_SCHED;
            PG8_STAGE(PG8_SB(0, 1), b2 + hstep, voffB);
            PG8_WAIT_V(6); PG8_BAR; PG8_MMA(1, 1, At, B1); PG8_BAR;
            PG8_LDB(B0, 1, 0); PG8_SCHED; PG8_LDA(At, 1, 0); PG8_STAGE(PG8_SA(0, 1), a2 + hstep, voffA);
            PG8_WAIT_L(8); PG8_BAR; PG8_WAIT_L(0); PG8_MMA(0, 0, At, B0); PG8_BAR; PG8_SCHED;
            PG8_LDB(B1, 1, 1); PG8_STAGE(PG8_SB(1, 0), b3, voffB);
            PG8_BAR; PG8_WAIT_L(0); PG8_MMA(0, 1, At, B1); PG8_BAR;
            PG8_LDA(At, 1, 1); PG8_STAGE(PG8_SA(1, 0), a3, voffA);
            PG8_BAR; PG8_WAIT_L(0); PG8_MMA(1, 0, At, B0); PG8_BAR; PG8_SCHED;
            PG8_STAGE(PG8_SB(1, 1), b3 + hstep, voffB);
            PG8_WAIT_V(6); PG8_BAR; PG8_MMA(1, 1, At, B1); PG8_BAR;
            }
        }
        if constexpr (ALIGN_EPI) { if (wr == 0) PG8_BAR; }
        E(acc, cur, wr, wc, fr, fq, pre_cur); S.done(cur);
        if (!has_next) break;
        pre_cur = pre_nxt;
#pragma unroll
        for (int a = 0; a < 2; ++a)
#pragma unroll
            for (int b = 0; b < 2; ++b)
#pragma unroll
                for (int m = 0; m < 4; ++m)
#pragma unroll
                    for (int n = 0; n < 2; ++n) acc[a][b][m][n] = (f32x4){0.f, 0.f, 0.f, 0.f};
        cur = nxt; cA = nA; cB = nB; ++ui;
        if constexpr (ALIGN_EPI) { if (wr == 1) PG8_BAR; }
    }
    PG8_WAIT_V(0);
    if constexpr (!ALIGN_EPI) { if (wr == 0) PG8_BAR; }
    PG8_BAR;
#undef PG8_SA
#undef PG8_SB
#undef PG8_STAGE
#undef PG8_LDA
#undef PG8_LDB
#undef PG8_MMA
#undef PG8_WAIT_V
#undef PG8_WAIT_L
#undef PG8_BAR
#undef PG8_SCHED
}

__device__ __forceinline__ float silu_mul(float g, float u) { return g * u * __builtin_amdgcn_rcpf(1.0f + __builtin_amdgcn_exp2f(-1.4426950408889634f * g)); }

struct PreNone {};
struct PreRows { float v[8]; };
__device__ __forceinline__ PreRows load_rows8(const float* ss, const Unit& u, int wr, int fr) {
    PreRows p; const float* b = ss + u.pm * BM + wr * 64 + fr;
#pragma unroll
    for (int ai = 0; ai < 2; ++ai)
#pragma unroll
        for (int m = 0; m < 4; ++m) p.v[ai * 4 + m] = b[ai * HALF + m * 16];
    return p;
}
struct EpiSwiglu {
    static constexpr bool PERM = true;
    typedef PreRows Pre;
    bf16_t* O; const float* ss;
    __device__ __forceinline__ Pre pre(const Unit& u, int wr, int fr) const { return load_rows8(ss, u, wr, fr); }
    __device__ __forceinline__ void operator()(const f32x4 (&acc)[2][2][4][2], const Unit& u, int wr, int wc, int fr, int fq, const Pre& pr) const {
        const int row0 = u.pm * BM + wr * 64 + fr, col0 = u.pn * HALF + wc * 32 + 8 * fq;
#pragma unroll
        for (int ai = 0; ai < 2; ++ai)
#pragma unroll
            for (int m = 0; m < 4; ++m) {
                const int row = row0 + ai * HALF + m * 16;
                const float rs = __builtin_amdgcn_rsqf(pr.v[ai * 4 + m] * (1.0f / D) + EPS);
                const f32x4 g0 = acc[ai][0][m][0] * rs, g1 = acc[ai][0][m][1] * rs, u0 = acc[ai][1][m][0] * rs, u1 = acc[ai][1][m][1] * rs;
                u32x4 w;
                w.x = cvt_pk_bf16(silu_mul(g0[0], u0[0]), silu_mul(g0[1], u0[1])); w.y = cvt_pk_bf16(silu_mul(g0[2], u0[2]), silu_mul(g0[3], u0[3]));
                w.z = cvt_pk_bf16(silu_mul(g1[0], u1[0]), silu_mul(g1[1], u1[1])); w.w = cvt_pk_bf16(silu_mul(g1[2], u1[2]), silu_mul(g1[3], u1[3]));
                *(u32x4*)(O + (size_t)row * FF + col0) = w;
            }
    }
};

template <bool BASE_BF16> struct EpiResid {
    static constexpr bool PERM = true;
    typedef PreNone Pre;
    const float* basef; const bf16_t* baseb; bf16_t* xb; float* ss; float alpha;
    __device__ __forceinline__ Pre pre(const Unit&, int, int) const { return Pre{}; }
    struct Row { f32x4 f[2][2]; u32x4 h[2]; };
    __device__ __forceinline__ void load(Row& r, size_t off) const {
#pragma unroll
        for (int bj = 0; bj < 2; ++bj) {
            if (BASE_BF16) r.h[bj] = *(const u32x4*)(baseb + off + bj * HALF);
            else { r.f[bj][0] = *(const f32x4*)(basef + off + bj * HALF); r.f[bj][1] = *(const f32x4*)(basef + off + bj * HALF + 4); } }
    }
    __device__ __forceinline__ void row(const Row& r, const f32x4 (&a)[2][2][4][2], int ai, int m, int row_, int col0, int fq) const {
        const size_t off = (size_t)row_ * D + col0; float sq = 0.f;
#pragma unroll
        for (int bj = 0; bj < 2; ++bj) {
            f32x4 b0, b1;
            if (BASE_BF16) { const u32x4 h = r.h[bj];
                b0 = (f32x4){__builtin_bit_cast(float, h[0] << 16), __builtin_bit_cast(float, h[0] & 0xffff0000u), __builtin_bit_cast(float, h[1] << 16), __builtin_bit_cast(float, h[1] & 0xffff0000u)};
                b1 = (f32x4){__builtin_bit_cast(float, h[2] << 16), __builtin_bit_cast(float, h[2] & 0xffff0000u), __builtin_bit_cast(float, h[3] << 16), __builtin_bit_cast(float, h[3] & 0xffff0000u)}; }
            else { b0 = r.f[bj][0]; b1 = r.f[bj][1]; }
            const f32x4 v0 = b0 + a[ai][bj][m][0] * alpha, v1 = b1 + a[ai][bj][m][1] * alpha;
            u32x4 w; w.x = cvt_pk_bf16(v0[0], v0[1]); w.y = cvt_pk_bf16(v0[2], v0[3]); w.z = cvt_pk_bf16(v1[0], v1[1]); w.w = cvt_pk_bf16(v1[2], v1[3]);
            *(u32x4*)(xb + off + bj * HALF) = w;
            sq += (v0[0] * v0[0] + v0[1] * v0[1]) + (v0[2] * v0[2] + v0[3] * v0[3]) + (v1[0] * v1[0] + v1[1] * v1[1]) + (v1[2] * v1[2] + v1[3] * v1[3]);
        }
        sq += __shfl_xor(sq, 16); sq += __shfl_xor(sq, 32);
        if (fq == 0) unsafeAtomicAdd(ss + row_, sq);
    }
    __device__ __forceinline__ void operator()(const f32x4 (&acc)[2][2][4][2], const Unit& u, int wr, int wc, int fr, int fq, const Pre&) const {
        const int row0 = u.pm * BM + wr * 64 + fr, col0 = u.pn * BM + wc * 32 + 8 * fq;
        Row pre[4];
#pragma unroll
        for (int m = 0; m < 4; ++m) load(pre[m], (size_t)(row0 + m * 16) * D + col0);
        asm volatile("" ::: "memory");
#pragma unroll
        for (int m = 0; m < 4; ++m) {
            row(pre[m], acc, 0, m, row0 + m * 16, col0, fq);
            load(pre[m], (size_t)(row0 + HALF + m * 16) * D + col0);
            asm volatile("" ::: "memory");
        }
#pragma unroll
        for (int m = 0; m < 4; ++m) { row(pre[m], acc, 1, m, row0 + HALF + m * 16, col0, fq); asm volatile("" ::: "memory"); }
    }
};

__device__ const float INVF[16] = {1.000000000e+00f, 4.403665960e-01f, 1.939227432e-01f, 8.539710194e-02f, 3.760603070e-02f, 1.656044088e-02f, 7.292664610e-03f, 3.211446106e-03f,
                                   1.414213562e-03f, 6.227724371e-04f, 2.742481884e-04f, 1.207697351e-04f, 5.318295734e-05f, 2.341999971e-05f, 1.031338525e-05f, 4.541670478e-06f};

struct EpiInProj {
    static constexpr bool PERM = false;
    typedef PreRows Pre;
    bf16_t* QKU; const float* ss; const int* pos; float* kmean;
    __device__ __forceinline__ Pre pre(const Unit& u, int wr, int fr) const { return load_rows8(ss, u, wr, fr); }
    __device__ __forceinline__ void operator()(f32x4 (&acc)[2][2][4][2], const Unit& u, int wr, int wc, int fr, int fq, const Pre& pr) const {
        const int row0 = u.pm * BM + wr * 64 + fr;
        const int kind = u.pn >> 2;
        const int ct = (u.pn & 3) * BM + wc * 32 + 4 * fq;
        bf16_t* dst = QKU + (size_t)kind * ((size_t)M * AW);
        float invf[4];
#pragma unroll
        for (int j = 0; j < 4; ++j) invf[j] = INVF[4 * fq + j];
#pragma unroll
        for (int ai = 0; ai < 2; ++ai)
#pragma unroll
            for (int m = 0; m < 4; ++m) {
                const int row = row0 + ai * HALF + m * 16;
                const float rs = __builtin_amdgcn_rsqf(pr.v[ai * 4 + m] * (1.0f / D) + EPS);
#pragma unroll
                for (int bj = 0; bj < 2; ++bj)
#pragma unroll
                    for (int n = 0; n < 2; ++n) acc[ai][bj][m][n] = acc[ai][bj][m][n] * rs;
                if (kind < 2 && wc == 0) {
                    const float p = (float)pos[row];
#pragma unroll
                    for (int j = 0; j < 4; ++j) {
                        const float ang = p * invf[j];
                        double rev = (double)ang * 0.15915494309189535; rev -= __builtin_floor(rev);
                        const float fr_ = (float)rev;
                        const float sn = __builtin_amdgcn_sinf(fr_), cs = __builtin_amdgcn_cosf(fr_);
#pragma unroll
                        for (int bj = 0; bj < 2; ++bj) { const float x1 = acc[ai][bj][m][0][j], x2 = acc[ai][bj][m][1][j];
                            acc[ai][bj][m][0][j] = x1 * cs - x2 * sn; acc[ai][bj][m][1][j] = x2 * cs + x1 * sn; }
                    }
                }
                const float qs = (kind == 0) ? QSCALE : 1.0f;
#pragma unroll
                for (int bj = 0; bj < 2; ++bj)
#pragma unroll
                    for (int n = 0; n < 2; ++n) { const f32x4 v = acc[ai][bj][m][n] * qs; u32x2 w; w.x = cvt_pk_bf16(v[0], v[1]); w.y = cvt_pk_bf16(v[2], v[3]);
                        *(u32x2*)(dst + (size_t)row * AW + ct + bj * HALF + n * 16) = w; }
            }
        if (kind == 1) {
            const int b = u.pm >> 4, blk = u.pm & 15;
#pragma unroll
            for (int bj = 0; bj < 2; ++bj)
#pragma unroll
                for (int n = 0; n < 2; ++n) {
                    f32x4 s = (f32x4){0.f, 0.f, 0.f, 0.f};
#pragma unroll
                    for (int ai = 0; ai < 2; ++ai)
#pragma unroll
                        for (int m = 0; m < 4; ++m) s += acc[ai][bj][m][n];
#pragma unroll
                    for (int j = 0; j < 4; ++j) { float v = s[j]; v += __shfl_xor(v, 1); v += __shfl_xor(v, 2); v += __shfl_xor(v, 4); v += __shfl_xor(v, 8); s[j] = v; }
                    if (fr == 0) { const int h = (u.pn & 3) * 2 + bj; float* km = kmean + ((size_t)((b * NH + h) * 16 + blk)) * HD + wc * 32 + n * 16 + 4 * fq;
#pragma unroll
                        for (int j = 0; j < 4; ++j) unsafeAtomicAdd(km + j, s[j] * (1.0f / 256.0f)); }
                }
        }
    }
};

struct EpiVT {
    static constexpr bool PERM = true;
    typedef PreNone Pre;
    bf16_t* VT; const float* ss;
    __device__ __forceinline__ Pre pre(const Unit&, int, int) const { return Pre{}; }
    __device__ __forceinline__ void operator()(const f32x4 (&acc)[2][2][4][2], const Unit& u, int wr, int wc, int fr, int fq, const Pre&) const {
        const int row0 = u.pm * BM + wr * 64 + fr, col0 = u.pn * BM + wc * 32 + 8 * fq;
        f32x4 rs[2][2];
#pragma unroll
        for (int bj = 0; bj < 2; ++bj)
#pragma unroll
            for (int n = 0; n < 2; ++n) { const f32x4 s = *(const f32x4*)(ss + col0 + bj * HALF + 4 * n);
#pragma unroll
                for (int j = 0; j < 4; ++j) rs[bj][n][j] = __builtin_amdgcn_rsqf(s[j] * (1.0f / D) + EPS); }
#pragma unroll
        for (int ai = 0; ai < 2; ++ai)
#pragma unroll
            for (int m = 0; m < 4; ++m) {
                const int row = row0 + ai * HALF + m * 16;
#pragma unroll
                for (int bj = 0; bj < 2; ++bj) { const f32x4 v0 = acc[ai][bj][m][0] * rs[bj][0], v1 = acc[ai][bj][m][1] * rs[bj][1];
                    u32x4 w; w.x = cvt_pk_bf16(v0[0], v0[1]); w.y = cvt_pk_bf16(v0[2], v0[3]); w.z = cvt_pk_bf16(v1[0], v1[1]); w.w = cvt_pk_bf16(v1[2], v1[3]);
                    *(u32x4*)(VT + (size_t)row * M + col0 + bj * HALF) = w; }
            }
    }
};

struct EpiPool {
    static constexpr bool PERM = true;
    typedef PreNone Pre;
    bf16_t* MIX; const float* pscale;
    __device__ __forceinline__ Pre pre(const Unit&, int, int) const { return Pre{}; }
    __device__ __forceinline__ void operator()(const f32x4 (&acc)[2][2][4][2], const Unit& u, int wr, int wc, int fr, int fq, const Pre&) const {
        const int g = u.pn; const int row0 = (u.pm - 64 * g) * BM + wr * 64 + fr, col0 = g * BM + wc * 32 + 8 * fq;
        f32x4 sc[2][2];
#pragma unroll
        for (int bj = 0; bj < 2; ++bj)
#pragma unroll
            for (int n = 0; n < 2; ++n) sc[bj][n] = *(const f32x4*)(pscale + col0 + bj * HALF + 4 * n);
#pragma unroll
        for (int ai = 0; ai < 2; ++ai)
#pragma unroll
            for (int m = 0; m < 4; ++m) {
                const int row = row0 + ai * HALF + m * 16;
#pragma unroll
                for (int bj = 0; bj < 2; ++bj) { const f32x4 v0 = acc[ai][bj][m][0] * sc[bj][0], v1 = acc[ai][bj][m][1] * sc[bj][1];
                    u32x4 w; w.x = cvt_pk_bf16(v0[0], v0[1]); w.y = cvt_pk_bf16(v0[2], v0[3]); w.z = cvt_pk_bf16(v1[0], v1[1]); w.w = cvt_pk_bf16(v1[2], v1[3]);
                    *(u32x4*)(MIX + (size_t)row * D + AW + col0 + bj * HALF) = w; }
            }
    }
};
}

namespace att {
constexpr int KROW = 272, VROW = 272, KT = 128 * KROW, VT_B = 128 * VROW;
constexpr int OFF_K = 0, OFF_V = 2 * KT, OFF_WS = 2 * KT + 2 * VT_B, LDS_NEED = OFF_WS + 8 * 256;

__device__ __forceinline__ int crow(int r, int hi) { return (r & 3) + 8 * (r >> 2) + 4 * hi; }

__device__ __forceinline__ void attn_unit(int b, int h, int qb, const bf16_t* __restrict__ Q, const bf16_t* __restrict__ K, const bf16_t* __restrict__ VT, const float* __restrict__ kmean,
                                          bf16_t* __restrict__ O, LAS unsigned char* lds) {
    int tid = threadIdx.x; asm volatile("" : "+v"(tid));
    const int lane = tid & 63, r32 = lane & 31, hi = lane >> 5; const int wid = __builtin_amdgcn_readfirstlane(tid >> 6);
    const size_t rowbase = (size_t)b * SEQ; const int q0 = qb * 256;
    const bf16_t* Qw = Q + (rowbase + q0 + wid * 32 + r32) * AW + h * HD + hi * 8;
    bf16x8 qf[8];
#pragma unroll
    for (int d0 = 0; d0 < 8; ++d0) qf[d0] = *(const bf16x8*)(Qw + d0 * 16);
    const bf16_t* gK = K + (rowbase + (tid >> 4)) * AW + h * HD + (tid & 15) * 8;
    const bf16_t* gV = VT + (size_t)(h * HD + (tid >> 4)) * M + rowbase + (tid & 15) * 8;
    const int lK = OFF_K + (tid >> 4) * KROW + (tid & 15) * 16, lV = OFF_V + (tid >> 4) * VROW + (tid & 15) * 16;
    const int pi32 = (r32 & 0x13) | ((r32 & 4) << 1) | ((r32 & 8) >> 1);
    const int kread = OFF_K + pi32 * KROW + hi * 16, vread = OFF_V + r32 * VROW + hi * 16;
    LAS float* wsf = (LAS float*)(lds + OFF_WS + wid * 256);
    const int NS = 2 * (qb + 1);
    LAS float* kml = (LAS float*)(lds + OFF_K + KT);
    f32x4 kmv = (f32x4){0.f, 0.f, 0.f, 0.f};
    if (tid < qb * 32) kmv = *(const f32x4*)(kmean + (size_t)((b * NH + h) * 16) * HD + tid * 4);
    u32x4 kr[4], vr[4];
#pragma unroll
    for (int i = 0; i < 4; ++i) { kr[i] = *(const u32x4*)(gK + (size_t)i * 32 * AW); vr[i] = *(const u32x4*)(gV + (size_t)i * 32 * M); }
    if (tid < qb * 32) *(LAS f32x4*)(kml + tid * 4) = kmv;
    __syncthreads();
    unsigned mask = 1u << qb;
    {
        float v1 = -3.0e38f, v2 = -3.0e38f, v3 = -3.0e38f; int i1 = -1, i2 = -1, i3 = -1;
        const LAS float* km = kml + hi * 8;
        for (int j = 0; j < qb; ++j) {
            float g = 0.f;
#pragma unroll
            for (int d0 = 0; d0 < 8; ++d0) { const f32x4 a = *(const LAS f32x4*)(km + j * HD + d0 * 16), c = *(const LAS f32x4*)(km + j * HD + d0 * 16 + 4);
                g += bf2f((unsigned short)qf[d0][0]) * a[0] + bf2f((unsigned short)qf[d0][1]) * a[1] + bf2f((unsigned short)qf[d0][2]) * a[2] + bf2f((unsigned short)qf[d0][3]) * a[3]
                   + bf2f((unsigned short)qf[d0][4]) * c[0] + bf2f((unsigned short)qf[d0][5]) * c[1] + bf2f((unsigned short)qf[d0][6]) * c[2] + bf2f((unsigned short)qf[d0][7]) * c[3]; }
            g += __shfl_xor(g, 32);
            if (g > v1) { v3 = v2; i3 = i2; v2 = v1; i2 = i1; v1 = g; i1 = j; }
            else if (g > v2) { v3 = v2; i3 = i2; v2 = g; i2 = j; }
            else if (g > v3) { v3 = g; i3 = j; }
        }
        if (i1 >= 0) mask |= 1u << i1; if (i2 >= 0) mask |= 1u << i2; if (i3 >= 0) mask |= 1u << i3;
    }
    unsigned wmask = 0;
    for (int j = 0; j <= qb; ++j) if (__any((int)((mask >> j) & 1u))) wmask |= 1u << j;
    wmask = __builtin_amdgcn_readfirstlane(wmask);
#pragma unroll
    for (int i = 0; i < 4; ++i) { *(LAS u32x4*)(lds + lK + i * 32 * KROW) = kr[i]; *(LAS u32x4*)(lds + lV + i * 32 * VROW) = vr[i]; }
    __syncthreads();
    float mrun = NEGBIG, lrun = 0.f;
    f32x16 o[4];
#pragma unroll
    for (int d = 0; d < 4; ++d)
#pragma unroll
        for (int r = 0; r < 16; ++r) o[d][r] = 0.f;
    const int qrel = wid * 32 + r32;
    for (int S = 0; S < NS; ++S) {
        const int cur = S & 1, j = S >> 1;
        if (S + 1 < NS) {
#pragma unroll
            for (int i = 0; i < 4; ++i) { kr[i] = *(const u32x4*)(gK + ((size_t)(S + 1) * 128 + i * 32) * AW); vr[i] = *(const u32x4*)(gV + (size_t)i * 32 * M + (S + 1) * 128); }
        }
        if ((wmask >> j) & 1u) {
#pragma unroll 1
          for (int u = 0; u < 2; ++u) {
            const int t = 2 * (S & 1) + u;
            if (j == qb && 64 * t > 32 * wid + 31) break;
            f32x16 p0, p1;
#pragma unroll
            for (int r = 0; r < 16; ++r) { p0[r] = 0.f; p1[r] = 0.f; }
            const LAS unsigned char* kb = lds + kread + cur * KT + u * 64 * KROW;
            const LAS unsigned char* vb = lds + vread + cur * VT_B + u * 128;
            bf16x8 ka[2][4];
#define ATT_LDK(B, G) do { ka[B][0] = *(const LAS bf16x8*)(kb + (2 * (G)) * 32); ka[B][1] = *(const LAS bf16x8*)(kb + 32 * KROW + (2 * (G)) * 32); \
                           ka[B][2] = *(const LAS bf16x8*)(kb + (2 * (G) + 1) * 32); ka[B][3] = *(const LAS bf16x8*)(kb + 32 * KROW + (2 * (G) + 1) * 32); } while (0)
            ATT_LDK(0, 0);
#pragma unroll
            for (int g = 0; g < 4; ++g) {
                if (g < 3) ATT_LDK((g + 1) & 1, g + 1);
                __builtin_amdgcn_sched_barrier(0);
                p0 = __builtin_amdgcn_mfma_f32_32x32x16_bf16(ka[g & 1][0], qf[2 * g], p0, 0, 0, 0);
                p1 = __builtin_amdgcn_mfma_f32_32x32x16_bf16(ka[g & 1][1], qf[2 * g], p1, 0, 0, 0);
                p0 = __builtin_amdgcn_mfma_f32_32x32x16_bf16(ka[g & 1][2], qf[2 * g + 1], p0, 0, 0, 0);
                p1 = __builtin_amdgcn_mfma_f32_32x32x16_bf16(ka[g & 1][3], qf[2 * g + 1], p1, 0, 0, 0);
                __builtin_amdgcn_sched_barrier(0);
            }
#undef ATT_LDK
            bf16x8 va[2][4];
#define ATT_LDV(B, C) do { _Pragma("unroll") for (int d = 0; d < 4; ++d) va[B][d] = *(const LAS bf16x8*)(vb + d * 32 * VROW + (C) * 32); } while (0)
            ATT_LDV(0, 0);
            __builtin_amdgcn_sched_barrier(0);
            const bool rowsel = (mask >> j) & 1u;
            if (j == qb) {
                const int kvb = 64 * t + 8 * hi;
#pragma unroll
                for (int r = 0; r < 16; ++r) { const int kv = kvb + 16 * (r >> 3) + (r & 7); if (kv > qrel) p0[r] = NEGBIG; if (kv + 32 > qrel) p1[r] = NEGBIG; }
            }
            float rm = fmaxf(p0[0], p1[0]);
#pragma unroll
            for (int r = 1; r < 16; ++r) rm = fmaxf(rm, fmaxf(p0[r], p1[r]));
            { const auto rr = __builtin_amdgcn_permlane32_swap(__float_as_uint(rm), __float_as_uint(rm), false, false); rm = fmaxf(__uint_as_float(rr[0]), __uint_as_float(rr[1])); }
            rm = rowsel ? rm : NEGBIG;
            const bool grow = rm > mrun + 8.0f;
            const float mnew = grow ? rm : mrun;
            const float alpha = grow ? __builtin_amdgcn_exp2f(mrun - mnew) : 1.0f;
            mrun = mnew;
            const float msub = rowsel ? mnew : 1e30f;
            p0 = p0 - msub; p1 = p1 - msub;
#pragma unroll
            for (int r = 0; r < 16; ++r) { p0[r] = __builtin_amdgcn_exp2f(p0[r]); p1[r] = __builtin_amdgcn_exp2f(p1[r]); }
            float sum;
            { const f32x16 s16 = p0 + p1;
              typedef float f32x8 __attribute__((ext_vector_type(8)));
              const f32x8 s8 = __builtin_shufflevector(s16, s16, 0, 1, 2, 3, 4, 5, 6, 7) + __builtin_shufflevector(s16, s16, 8, 9, 10, 11, 12, 13, 14, 15);
              const f32x4 s4 = __builtin_shufflevector(s8, s8, 0, 1, 2, 3) + __builtin_shufflevector(s8, s8, 4, 5, 6, 7);
              sum = (s4[0] + s4[1]) + (s4[2] + s4[3]); }
            lrun = lrun * alpha + sum;
            if (__any(grow)) {
                if (hi == 0) wsf[r32] = alpha;
                asm volatile("s_waitcnt lgkmcnt(0)" ::: "memory");
#pragma unroll
                for (int gq = 0; gq < 4; ++gq) { const f32x4 a = *(const LAS f32x4*)(wsf + 8 * gq + 4 * hi);
#pragma unroll
                    for (int d = 0; d < 4; ++d) { o[d][4 * gq + 0] *= a[0]; o[d][4 * gq + 1] *= a[1]; o[d][4 * gq + 2] *= a[2]; o[d][4 * gq + 3] *= a[3]; } }
                asm volatile("s_waitcnt lgkmcnt(0)" ::: "memory");
            }
            bf16x8 pw[4];
            { u32x4 w;
              w.x = cvt_pk_bf16(p0[0], p0[1]); w.y = cvt_pk_bf16(p0[2], p0[3]); w.z = cvt_pk_bf16(p0[4], p0[5]); w.w = cvt_pk_bf16(p0[6], p0[7]); pw[0] = __builtin_bit_cast(bf16x8, w);
              w.x = cvt_pk_bf16(p0[8], p0[9]); w.y = cvt_pk_bf16(p0[10], p0[11]); w.z = cvt_pk_bf16(p0[12], p0[13]); w.w = cvt_pk_bf16(p0[14], p0[15]); pw[1] = __builtin_bit_cast(bf16x8, w);
              w.x = cvt_pk_bf16(p1[0], p1[1]); w.y = cvt_pk_bf16(p1[2], p1[3]); w.z = cvt_pk_bf16(p1[4], p1[5]); w.w = cvt_pk_bf16(p1[6], p1[7]); pw[2] = __builtin_bit_cast(bf16x8, w);
              w.x = cvt_pk_bf16(p1[8], p1[9]); w.y = cvt_pk_bf16(p1[10], p1[11]); w.z = cvt_pk_bf16(p1[12], p1[13]); w.w = cvt_pk_bf16(p1[14], p1[15]); pw[3] = __builtin_bit_cast(bf16x8, w); }
            __builtin_amdgcn_sched_barrier(0);
#pragma unroll
            for (int c = 0; c < 4; ++c) {
                if (c < 3) ATT_LDV((c + 1) & 1, c + 1);
                __builtin_amdgcn_sched_barrier(0);
#pragma unroll
                for (int d = 0; d < 4; ++d) o[d] = __builtin_amdgcn_mfma_f32_32x32x16_bf16(pw[c], va[c & 1][d], o[d], 0, 0, 0);
                __builtin_amdgcn_sched_barrier(0);
            }
#undef ATT_LDV
          }
        }
        if (S + 1 < NS) {
            const int nb = cur ^ 1;
#pragma unroll
            for (int i = 0; i < 4; ++i) { *(LAS u32x4*)(lds + lK + nb * KT + i * 32 * KROW) = kr[i]; *(LAS u32x4*)(lds + lV + nb * VT_B + i * 32 * VROW) = vr[i]; }
        }
        __syncthreads();
    }
    lrun += __shfl_xor(lrun, 32);
    const float inv = 1.0f / lrun;
    if (hi == 0) wsf[r32] = inv;
    asm volatile("s_waitcnt lgkmcnt(0)" ::: "memory");
    bf16_t* Ow = O + (rowbase + q0 + wid * 32) * D + h * HD + r32;
#pragma unroll
    for (int gq = 0; gq < 4; ++gq) { const f32x4 a = *(const LAS f32x4*)(wsf + 8 * gq + 4 * hi);
#pragma unroll
        for (int jj = 0; jj < 4; ++jj) { const int r = 4 * gq + jj; const int orow = crow(r, hi);
#pragma unroll
            for (int d = 0; d < 4; ++d) { const unsigned w = cvt_pk_bf16(o[d][r] * a[jj], 0.f); Ow[(size_t)orow * D + d * 32] = (bf16_t)(w & 0xffffu); } } }
    asm volatile("s_waitcnt lgkmcnt(0)" ::: "memory");
    __syncthreads();
}
}


#define XB_TMO      128
#define XB_XCNT(j)  (256  + 64 * (j))
#define XB_XSUB(j)  (1280 + 64 * (j))
#define XB_XGEN(j)  (2304 + 64 * (j))
#define XB_TOP      3328
#define XB_TOPGEN   3392
#define XCD_BAR_WORDS 3456
#define XB_SPIN_CAP (1u << 18)
__device__ __forceinline__ unsigned xb_ld(unsigned* p)              { return __hip_atomic_load(p, __ATOMIC_RELAXED, __HIP_MEMORY_SCOPE_AGENT); }
__device__ __forceinline__ unsigned xb_add(unsigned* p, unsigned v) { return __hip_atomic_fetch_add(p, v, __ATOMIC_RELAXED, __HIP_MEMORY_SCOPE_AGENT); }
__device__ __forceinline__ unsigned xb_xcc_id() { return (unsigned)__builtin_amdgcn_s_getreg((3 << 11) | 20) & 0xFu; }
#define XB_SPIN(cond, bar) do { unsigned _sp = 0; while (cond) { __builtin_amdgcn_s_sleep(1); \
    if ((++_sp & 255u) == 0u) { if (xb_ld(&(bar)[XB_TMO])) break; if (_sp > XB_SPIN_CAP) { atomicAdd(&(bar)[XB_TMO], 1u); break; } } } } while (0)
struct XcdBarrier { unsigned* bar; unsigned x; volatile LAS unsigned* st; };
__device__ __forceinline__ XcdBarrier xcd_barrier_post(unsigned* bar, volatile LAS unsigned* st) {
    XcdBarrier b; b.bar = bar; b.x = xb_xcc_id(); b.st = st;
    if (threadIdx.x == 0) (void)xb_add(&bar[XB_XCNT(b.x)], 1u);
    return b;
}
__device__ __forceinline__ void xcd_barrier_complete(unsigned* bar, unsigned x, unsigned& nloc, unsigned& nx) {
    const unsigned G = gridDim.x * gridDim.y * gridDim.z;
    unsigned sum, cnt, mine, sp = 0u;
    for (;;) {
        sum = 0u; cnt = 0u; mine = 0u;
#pragma unroll
        for (unsigned j = 0; j < 16; ++j) { const unsigned c = xb_ld(&bar[XB_XCNT(j)]); sum += c; cnt += (c > 0u) ? 1u : 0u; mine = (j == x) ? c : mine; }
        if (sum == G) break;
        __builtin_amdgcn_s_sleep(1);
        if ((++sp & 255u) == 0u) { if (xb_ld(&bar[XB_TMO])) break; if (sp > XB_SPIN_CAP) { atomicAdd(&bar[XB_TMO], 1u); break; } }
    }
    nloc = mine > 0u ? mine : 1u; nx = cnt > 0u ? cnt : 1u;
}
__device__ __forceinline__ void xcd_barrier(const XcdBarrier& b) {
    asm volatile("s_waitcnt vmcnt(0)" ::: "memory");
    __syncthreads();
    if (threadIdx.x == 0) {
        unsigned* bar = b.bar;
        __builtin_amdgcn_s_waitcnt(0);
        unsigned nloc = b.st[0], nx = b.st[1];
        if (nloc == 0u) { xcd_barrier_complete(bar, b.x, nloc, nx); b.st[0] = nloc; b.st[1] = nx; }
        const unsigned old = xb_add(&bar[XB_XSUB(b.x)], 1u);
        const unsigned gen = old / nloc;
        if (old + 1u == (gen + 1u) * nloc) {
            __builtin_amdgcn_fence(__ATOMIC_RELEASE, "agent");
            asm volatile("s_waitcnt vmcnt(0)" ::: "memory");
            const unsigned og = xb_add(&bar[XB_TOP], 1u);
            const unsigned tg = og / nx;
            if (og + 1u == (tg + 1u) * nx) xb_add(&bar[XB_TOPGEN], 1u);
            else XB_SPIN(xb_ld(&bar[XB_TOPGEN]) == tg, bar);
            __builtin_amdgcn_fence(__ATOMIC_ACQUIRE, "agent");
            xb_add(&bar[XB_XGEN(b.x)], 1u);
            asm volatile("s_waitcnt vmcnt(0)" ::: "memory");
        } else {
            XB_SPIN(xb_ld(&bar[XB_XGEN(b.x)]) == gen, bar);
            __builtin_amdgcn_fence(__ATOMIC_ACQUIRE, "agent");
            asm volatile("s_waitcnt vmcnt(0)" ::: "memory");
        }
    }
    __syncthreads();
}

constexpr int NWAVES = 8;
constexpr int LDS_BYTES = 147456, LDS_MISC = 147200;
constexpr size_t al256(size_t x) { return (x + 255) & ~(size_t)255; }
constexpr size_t WS_CTL = 0, CTL_BYTES = 16384;
constexpr size_t WS_SS = CTL_BYTES;
constexpr size_t WS_KMEAN = WS_SS + (size_t)4 * M * 4;
constexpr size_t WS_WGU1 = WS_KMEAN + (size_t)4 * NH * 16 * HD * 4;
constexpr size_t WS_WD1 = WS_WGU1 + (size_t)2 * FF * D * 2;
constexpr size_t WS_WIN = WS_WD1 + (size_t)D * FF * 2;
constexpr size_t WS_WPOOL = WS_WIN + (size_t)4096 * D * 2;
constexpr size_t WS_WOUT = WS_WPOOL + (size_t)1024 * 256 * 2;
constexpr size_t WS_WGU2 = WS_WOUT + (size_t)D * D * 2;
constexpr size_t WS_WD2 = WS_WGU2 + (size_t)2 * FF * D * 2;
constexpr size_t WS_XB = WS_WD2 + (size_t)D * FF * 2;
constexpr size_t WS_ACT = WS_XB + (size_t)M * D * 2;
constexpr size_t WS_Q = WS_ACT, WS_K = WS_Q + (size_t)M * AW * 2, WS_U = WS_K + (size_t)M * AW * 2, WS_VT = WS_U + (size_t)M * AW * 2, WS_PL = WS_VT + (size_t)M * AW * 2;
constexpr size_t WS_MIX = WS_ACT + (size_t)M * FF * 2;
constexpr size_t WS_END = WS_MIX + (size_t)M * D * 2;
static_assert(WS_PL + (size_t)M * AW * 2 <= WS_MIX, "overlay fits");

struct Args { const float* in[16]; float* out; unsigned char* ws; };

__device__ __forceinline__ float wave_sum(float v) {
#pragma unroll
    for (int o = 1; o < 64; o <<= 1) v += __shfl_xor(v, o);
    return v;
}
__device__ __forceinline__ void transpose_item(const float* __restrict__ W, int N, int k0, int n0, const float* __restrict__ gain, bf16_t* dst, int ldt, LAS float* scr, int lane) {
    f32x4 v[16];
    const int lr = lane >> 4, lc = 4 * (lane & 15);
#pragma unroll
    for (int i = 0; i < 16; ++i) v[i] = *(const f32x4*)(W + (size_t)(k0 + 4 * i + lr) * N + n0 + lc);
    if (gain) {
#pragma unroll
        for (int i = 0; i < 16; ++i) v[i] = v[i] * gain[k0 + 4 * i + lr];
    }
#pragma unroll
    for (int i = 0; i < 16; ++i) { LAS float* d = scr + (4 * i + lr) * 65 + lc; d[0] = v[i][0]; d[1] = v[i][1]; d[2] = v[i][2]; d[3] = v[i][3]; }
    asm volatile("s_waitcnt lgkmcnt(0)" ::: "memory");
    const int c = lane >> 3, nl = lane & 7;
#pragma unroll
    for (int j = 0; j < 8; ++j) { const int n = nl + 8 * j; const LAS float* s = scr + (8 * c) * 65 + n;
        u32x4 o; o.x = cvt_pk_bf16(s[0 * 65], s[1 * 65]); o.y = cvt_pk_bf16(s[2 * 65], s[3 * 65]); o.z = cvt_pk_bf16(s[4 * 65], s[5 * 65]); o.w = cvt_pk_bf16(s[6 * 65], s[7 * 65]);
        *(u32x4*)(dst + (size_t)n * ldt + 8 * c) = o; }
    asm volatile("s_waitcnt lgkmcnt(0)" ::: "memory");
}
__device__ __forceinline__ int dest_row(int mode, int n) {
    if (mode == 1) return (n >> 7) * 256 + (n & 127);
    if (mode == 2) return (n >> 7) * 256 + 128 + (n & 127);
    if (mode == 3) return n < 2048 ? n : (n < 3072 ? n + 1024 : n - 1024);
    return n;
}
__device__ __forceinline__ void transpose_mat(const float* W, int K, int N, const float* gain, bf16_t* WT, int mode, int item, LAS float* scr, int lane) {
    const int nblk = N / 64, kb = item / nblk, nb = item % nblk;
    transpose_item(W, N, 64 * kb, 64 * nb, gain, WT + (size_t)dest_row(mode, 64 * nb) * K + 64 * kb, K, scr, lane);
}

template <int WIN> __device__ __forceinline__ void pooled_tile(const bf16_t* __restrict__ UB, bf16_t* __restrict__ PL, int g, int pm, int tidp) {
#pragma unroll 1
    for (int pass = 0; pass < 2; ++pass) {
        const int chunk = tidp & 31, seg = (tidp >> 5) + 16 * pass;
        const int r0 = pm * 256 + seg * 8, sq0 = r0 & (SEQ - 1);
        const bf16_t* up = UB + (size_t)r0 * AW + g * 256 + chunk * 8;
        u32x4 rows[7 + WIN];
#pragma unroll
        for (int k = 0; k < 7 + WIN; ++k) { const int rel = k - (WIN - 1);
            rows[k] = (sq0 + rel >= 0) ? *(const u32x4*)(up + (long)rel * AW) : (u32x4){0u, 0u, 0u, 0u}; }
        float sm[8];
#pragma unroll
        for (int j = 0; j < 8; ++j) sm[j] = 0.f;
#pragma unroll
        for (int k = 0; k < WIN; ++k)
#pragma unroll
            for (int j = 0; j < 4; ++j) { sm[2 * j] += __builtin_bit_cast(float, rows[k][j] << 16); sm[2 * j + 1] += __builtin_bit_cast(float, rows[k][j] & 0xffff0000u); }
#pragma unroll
        for (int i = 0; i < 8; ++i) {
            if (i > 0) {
#pragma unroll
                for (int j = 0; j < 4; ++j) {
                    sm[2 * j] += __builtin_bit_cast(float, rows[WIN - 1 + i][j] << 16) - __builtin_bit_cast(float, rows[i - 1][j] << 16);
                    sm[2 * j + 1] += __builtin_bit_cast(float, rows[WIN - 1 + i][j] & 0xffff0000u) - __builtin_bit_cast(float, rows[i - 1][j] & 0xffff0000u); }
            }
            const int c = sq0 + i + 1; const float ic = 1.0f / (float)(c < WIN ? c : WIN);
            const u32x4 self = rows[WIN - 1 + i]; u32x4 o;
#pragma unroll
            for (int j = 0; j < 4; ++j) o[j] = cvt_pk_bf16(sm[2 * j] * ic - __builtin_bit_cast(float, self[j] << 16), sm[2 * j + 1] * ic - __builtin_bit_cast(float, self[j] & 0xffff0000u));
            *(u32x4*)(PL + ((size_t)g * M + r0 + i) * 256 + chunk * 8) = o;
        }
    }
}

__global__ void __launch_bounds__(NWAVES * 64, 2) fwd_kernel(Args args) {
    extern __shared__ __attribute__((aligned(16))) unsigned char lds_raw[];
    LAS unsigned char* lds = (LAS unsigned char*)lds_raw;
    cg::grid_group grid = cg::this_grid();
    const int tid = threadIdx.x, lane = tid & 63; const int wave = __builtin_amdgcn_readfirstlane(tid >> 6);
    if (tid < 16) ((LAS unsigned*)(lds + LDS_MISC))[tid] = 0u;
    __syncthreads();
    const XcdBarrier xbar = xcd_barrier_post((unsigned*)(args.ws + WS_CTL), (volatile LAS unsigned*)(lds + LDS_MISC));
    if (args.ws == nullptr) grid.sync();
    const int G = gridDim.x, bx = blockIdx.x;
    const int vcu = (G % 8 == 0) ? (bx % 8) * (G / 8) + bx / 8 : bx;
    unsigned char* ws = args.ws;
    const float* x = args.in[0]; const int* pos = (const int*)args.in[1];
    const float *g_ffn1 = args.in[2], *w1g = args.in[3], *w1u = args.in[4], *w1d = args.in[5], *g_mix = args.in[6], *w_in = args.in[7], *pool_w = args.in[8], *pool_scale = args.in[9],
                *w_out = args.in[10], *g_ffn2 = args.in[11], *w2g = args.in[12], *w2u = args.in[13], *w2d = args.in[14], *g_fin = args.in[15];
    float* out = args.out;
    float* ss0 = (float*)(ws + WS_SS); float* ss1 = ss0 + M; float* ss2 = ss1 + M; float* ss3 = ss2 + M;
    float* kmean = (float*)(ws + WS_KMEAN);
    bf16_t *WGU1 = (bf16_t*)(ws + WS_WGU1), *WD1 = (bf16_t*)(ws + WS_WD1), *WIN = (bf16_t*)(ws + WS_WIN), *WPOOL = (bf16_t*)(ws + WS_WPOOL), *WOUT = (bf16_t*)(ws + WS_WOUT),
           *WGU2 = (bf16_t*)(ws + WS_WGU2), *WD2 = (bf16_t*)(ws + WS_WD2);
    bf16_t *XB = (bf16_t*)(ws + WS_XB), *ACT = (bf16_t*)(ws + WS_ACT), *QB = (bf16_t*)(ws + WS_Q), *KB = (bf16_t*)(ws + WS_K), *VTB = (bf16_t*)(ws + WS_VT), *UB = (bf16_t*)(ws + WS_U),
           *PL = (bf16_t*)(ws + WS_PL), *MIX = (bf16_t*)(ws + WS_MIX);
    const int gw = vcu * NWAVES + wave, NGW = G * NWAVES;
    const int gt = bx * (NWAVES * 64) + tid, NGT = G * NWAVES * 64;

    for (int rep = 0; rep < REP_P0; ++rep) {
        for (int i = gt; i < 3 * M; i += NGT) ss1[i] = 0.f;
        for (int i = gt; i < 4 * NH * 16 * HD; i += NGT) kmean[i] = 0.f;
        LAS float* scr = (LAS float*)(lds + wave * 16640);
        constexpr int I_GU = (D / 64) * (FF / 64), I_DN = (FF / 64) * (D / 64), I_IN = (D / 64) * (4096 / 64), I_PW = (256 / 64) * (256 / 64), I_OUT = (D / 64) * (D / 64);
        constexpr int NITEMS = 4 * I_GU + 2 * I_DN + I_IN + 4 * I_PW + I_OUT;
        for (int it = gw; it < NITEMS; it += NGW) {
            int r = it;
            if (r < I_GU) { transpose_mat(w1g, D, FF, g_ffn1, WGU1, 1, r, scr, lane); continue; } r -= I_GU;
            if (r < I_GU) { transpose_mat(w1u, D, FF, g_ffn1, WGU1, 2, r, scr, lane); continue; } r -= I_GU;
            if (r < I_DN) { transpose_mat(w1d, FF, D, nullptr, WD1, 0, r, scr, lane); continue; } r -= I_DN;
            if (r < I_IN) { transpose_mat(w_in, D, 4096, g_mix, WIN, 3, r, scr, lane); continue; } r -= I_IN;
            if (r < 4 * I_PW) { const int g = r / I_PW; transpose_mat(pool_w + (size_t)g * 65536, 256, 256, nullptr, WPOOL + (size_t)g * 65536, 0, r % I_PW, scr, lane); continue; } r -= 4 * I_PW;
            if (r < I_OUT) { transpose_mat(w_out, D, D, nullptr, WOUT, 0, r, scr, lane); continue; } r -= I_OUT;
            if (r < I_GU) { transpose_mat(w2g, D, FF, g_ffn2, WGU2, 1, r, scr, lane); continue; } r -= I_GU;
            if (r < I_GU) { transpose_mat(w2u, D, FF, g_ffn2, WGU2, 2, r, scr, lane); continue; } r -= I_GU;
            transpose_mat(w2d, FF, D, nullptr, WD2, 0, r, scr, lane);
        }
        for (int m = gw; m < M; m += NGW) {
            const f32x4* xr = (const f32x4*)(x + (size_t)m * D) + lane; float s = 0.f; f32x4 v[8];
#pragma unroll
            for (int j = 0; j < 8; ++j) { v[j] = xr[64 * j]; s += (v[j][0] * v[j][0] + v[j][1] * v[j][1]) + (v[j][2] * v[j][2] + v[j][3] * v[j][3]); }
            s = wave_sum(s);
            u32x2* o8 = (u32x2*)(XB + (size_t)m * D) + lane;
#pragma unroll
            for (int j = 0; j < 8; ++j) { u32x2 w; w.x = cvt_pk_bf16(v[j][0], v[j][1]); w.y = cvt_pk_bf16(v[j][2], v[j][3]); o8[64 * j] = w; }
            if (lane == 0) ss0[m] = s;
        }
    }
    xcd_barrier(xbar);
    for (int rep = 0; rep < REP_P1; ++rep) { pg8::Gemm g{XB, WGU1, M, 2 * FF, D}; pg8::StaticOrder S; S.init(M, 2 * FF, G, bx); pg8::EpiSwiglu E{ACT, ss0};
      pg8::gemm_phase<pg8::EpiSwiglu, pg8::StaticOrder, true, true>(lds, g, S, E); }
    xcd_barrier(xbar);
    { pg8::Gemm g{ACT, WD1, M, D, FF}; pg8::StaticOrder S; S.init(M, D, G, bx); pg8::EpiResid<true> E{nullptr, XB, XB, ss1, 0.5f};
      pg8::gemm_phase<pg8::EpiResid<true>, pg8::StaticOrder, true, true>(lds, g, S, E); }
    xcd_barrier(xbar);
    { pg8::Gemm g{XB, WIN, M, NQKU, D}; pg8::StaticOrder S; S.init(M, NQKU, G, bx); pg8::EpiInProj E{QB, ss1, pos, kmean};
      pg8::gemm_phase<pg8::EpiInProj, pg8::StaticOrder, true, true>(lds, g, S, E); }
    { pg8::Gemm g{WIN + (size_t)NQKU * D, XB, AW, M, D}; pg8::StaticOrder S; S.init(AW, M, G, bx); pg8::EpiVT E{VTB, ss1};
      pg8::gemm_phase<pg8::EpiVT, pg8::StaticOrder, true, true>(lds, g, S, E); }
    xcd_barrier(xbar);
    {
        for (int rep = 0; rep < REP_ATT; ++rep)
        for (int pr = vcu; pr < 256; pr += G) {
            const int bh = pr >> 3, s = pr & 7;
#pragma nounroll
            for (int k2 = 0; k2 < 2; ++k2) att::attn_unit(bh >> 3, bh & 7, k2 ? s : 15 - s, QB, KB, VTB, kmean, MIX, lds);
        }
        int tidp = threadIdx.x; asm volatile("" : "+v"(tidp));
        for (int L = bx; L < 256; L += G) {
            const int g = L >> 6, pm = L & 63;
            if (g == 0) pooled_tile<2>(UB, PL, g, pm, tidp); else if (g == 1) pooled_tile<4>(UB, PL, g, pm, tidp); else if (g == 2) pooled_tile<8>(UB, PL, g, pm, tidp); else pooled_tile<16>(UB, PL, g, pm, tidp);
            asm volatile("s_waitcnt vmcnt(0)" ::: "memory");
            __syncthreads();
            int Kp = 256; asm volatile("" : "+s"(Kp));
            pg8::Gemm gm{PL, WPOOL, 4 * M, 1024, Kp}; pg8::OneUnit S; S.u0.pm = g * 64 + pm; S.u0.pn = g; pg8::EpiPool E{MIX, pool_scale};
            pg8::gemm_phase<pg8::EpiPool, pg8::OneUnit, false, true>(lds, gm, S, E);
        }
    }
    xcd_barrier(xbar);
    { pg8::Gemm g{MIX, WOUT, M, D, D}; pg8::StaticOrder S; S.init(M, D, G, bx); pg8::EpiResid<true> E{nullptr, XB, XB, ss2, 1.0f};
      pg8::gemm_phase<pg8::EpiResid<true>, pg8::StaticOrder, true, true>(lds, g, S, E); }
    xcd_barrier(xbar);
    { pg8::Gemm g{XB, WGU2, M, 2 * FF, D}; pg8::StaticOrder S; S.init(M, 2 * FF, G, bx); pg8::EpiSwiglu E{ACT, ss2};
      pg8::gemm_phase<pg8::EpiSwiglu, pg8::StaticOrder, true, true>(lds, g, S, E); }
    xcd_barrier(xbar);
    { pg8::Gemm g{ACT, WD2, M, D, FF}; pg8::StaticOrder S; S.init(M, D, G, bx); pg8::EpiResid<true> E{nullptr, XB, XB, ss3, 0.5f};
      pg8::gemm_phase<pg8::EpiResid<true>, pg8::StaticOrder, true, true>(lds, g, S, E); }
    xcd_barrier(xbar);
    int lane8 = threadIdx.x & 63; asm volatile("" : "+v"(lane8));
    for (int m = gw; m < M; m += NGW) {
        const u32x4* xr = (const u32x4*)(XB + (size_t)m * D) + lane8; f32x4* orow = (f32x4*)(out + (size_t)m * D) + 2 * lane8; const f32x4* gr = (const f32x4*)g_fin + 2 * lane8;
        const float rs = __builtin_amdgcn_rsqf(ss3[m] * (1.0f / D) + EPS);
#pragma unroll
        for (int j = 0; j < 4; ++j) { const u32x4 h = xr[64 * j]; const f32x4 g0 = gr[128 * j], g1 = gr[128 * j + 1];
            const f32x4 v0 = (f32x4){__builtin_bit_cast(float, h[0] << 16), __builtin_bit_cast(float, h[0] & 0xffff0000u), __builtin_bit_cast(float, h[1] << 16), __builtin_bit_cast(float, h[1] & 0xffff0000u)};
            const f32x4 v1 = (f32x4){__builtin_bit_cast(float, h[2] << 16), __builtin_bit_cast(float, h[2] & 0xffff0000u), __builtin_bit_cast(float, h[3] << 16), __builtin_bit_cast(float, h[3] & 0xffff0000u)};
            orow[128 * j] = v0 * rs * g0; orow[128 * j + 1] = v1 * rs * g1; }
    }
}

extern "C" void kernel_launch(void* const* d_in, const int* in_sizes, int n_in, void* d_out, int out_size, void* d_ws, size_t ws_size, hipStream_t stream) {
    static int grid = 0;
    if (grid == 0) {
        if (n_in != 16 || out_size != M * D || ws_size < WS_END) { fprintf(stderr, "kernel_launch: unexpected problem (n_in %d out %d ws %zu need %zu)\n", n_in, out_size, ws_size, (size_t)WS_END); grid = -1; return; }
        int dev = 0, cus = 0, per_cu = 0;
        (void)hipGetDevice(&dev);
        (void)hipDeviceGetAttribute(&cus, hipDeviceAttributeMultiprocessorCount, dev);
        (void)hipFuncSetAttribute((const void*)fwd_kernel, hipFuncAttributeMaxDynamicSharedMemorySize, LDS_BYTES);
        (void)hipOccupancyMaxActiveBlocksPerMultiprocessor(&per_cu, (const void*)fwd_kernel, NWAVES * 64, LDS_BYTES);
        if (per_cu < 1) { fprintf(stderr, "kernel_launch: occupancy query says %d blocks per CU\n", per_cu); per_cu = 1; }
        grid = cus;
    }
    if (grid < 0) return;
    if (hipMemsetAsync((char*)d_ws + WS_CTL, 0, CTL_BYTES, stream) != hipSuccess) { fprintf(stderr, "kernel_launch: memset of barrier words failed\n"); return; }
    Args a{};
    for (int i = 0; i < 16; ++i) a.in[i] = (const float*)d_in[i];
    a.out = (float*)d_out; a.ws = (unsigned char*)d_ws;
    void* kargs[] = {&a};
    hipError_t e = hipLaunchCooperativeKernel((const void*)fwd_kernel, dim3(grid), dim3(NWAVES * 64), kargs, LDS_BYTES, stream);
    if (e != hipSuccess) fprintf(stderr, "cooperative launch failed: %s (grid %d)\n", hipGetErrorString(e), grid);
}
```

```cpp
#include <hip/hip_runtime.h>
#include <hip/hip_cooperative_groups.h>
#include <cstdio>
#include <cstdint>
namespace cg = cooperative_groups;
#ifndef REP_P0
#define REP_P0 1
#endif
#ifndef REP_P1
#define REP_P1 1
#endif
#ifndef REP_ATT
#define REP_ATT 1
#endif

#define LAS __attribute__((address_space(3)))
typedef unsigned short bf16_t;
typedef short bf16x8 __attribute__((ext_vector_type(8)));
typedef float f32x4 __attribute__((ext_vector_type(4)));
typedef float f32x16 __attribute__((ext_vector_type(16)));
typedef unsigned u32x4 __attribute__((ext_vector_type(4)));
typedef unsigned u32x2 __attribute__((ext_vector_type(2)));

constexpr int M = 16384, SEQ = 4096, D = 2048, FF = 5632, AW = 1024, NH = 8, HD = 128;
constexpr int NQKU = 3072;
constexpr float EPS = 1e-6f;
constexpr float NEGBIG = -1e30f;
constexpr float QSCALE = 0.08838834764831845f * 1.4426950408889634f;

__device__ __forceinline__ unsigned cvt_pk_bf16(float lo, float hi) { unsigned r; asm volatile("v_cvt_pk_bf16_f32 %0, %1, %2" : "=v"(r) : "v"(lo), "v"(hi)); return r; }
__device__ __forceinline__ float bf2f(unsigned short b) { return __builtin_bit_cast(float, (unsigned)b << 16); }

namespace pg8 {
constexpr int BM = 256, BK = 64, HALF = 128, HTB = HALF * BK * 2, STAGE_BYTES = 8 * HTB, NXCD = 8, WGM = 8;
__host__ __device__ __forceinline__ int lds_byte(int r, int c) { const int st = (r >> 4) * 2 + (c >> 5), rr = r & 15, cc = c & 31, ob = rr * 64 + cc * 2; return st * 1024 + (ob ^ (((ob >> 9) & 1) << 5)); }
__host__ __device__ __forceinline__ void stage_rc(int b, int& R, int& C) { const int st = b / 1024, sb = b % 1024, swz = sb ^ (((sb >> 9) & 1) << 5); R = (st >> 1) * 16 + swz / 64; C = (st & 1) * 32 + (swz % 64) / 2; }
__host__ __device__ __forceinline__ int perm32(int rho) { const int n = rho >> 4, i = rho & 15; return 8 * (i >> 2) + 4 * n + (i & 3); }

struct Unit { int pm, pn; };
struct Gemm { const bf16_t* A; const bf16_t* Bt; int M, N, K; };

struct StaticOrder {
    int nM, nN, nwg, G, c;
    __device__ void init(int M_, int N_, int G_, int c_) { nM = M_ / BM; nN = N_ / BM; nwg = nM * nN; G = G_; c = c_; }
    __device__ bool next(int i, Unit& u) const {
        const long L = (long)i * G + c; if (L >= nwg) return false;
        int wgid = (int)L; { const int q = nwg / NXCD, r = nwg % NXCD, xcd = wgid % NXCD, off = wgid / NXCD; wgid = (xcd < r ? xcd * (q + 1) : r * (q + 1) + (xcd - r) * q) + off; }
        const int nig = WGM * nN, gid = wgid / nig, fm = gid * WGM, gsz = (nM - fm) < WGM ? (nM - fm) : WGM;
        u.pm = fm + ((wgid % nig) % gsz); u.pn = (wgid % nig) / gsz; return true;
    }
    __device__ __forceinline__ void a_ready(const Unit&) const {}
    __device__ __forceinline__ void done(const Unit&) const {}
};
struct OneUnit {
    Unit u0;
    __device__ bool next(int i, Unit& u) const { if (i > 0) return false; u = u0; return true; }
    __device__ __forceinline__ void a_ready(const Unit&) const {}
    __device__ __forceinline__ void done(const Unit&) const {}
};

template <class Epi, class Sched, bool ALIGN_EPI = false, bool SP2 = false>
__device__ __forceinline__ void gemm_phase(LAS unsigned char* lds, const Gemm g, const Sched& S, const Epi& E) {
    int tid = threadIdx.x; asm volatile("" : "+v"(tid));
    const int wid = __builtin_amdgcn_readfirstlane(tid >> 6), lane = tid & 63, wr = wid >> 2, wc = wid & 3, fr = lane & 15, fq = lane >> 4;
    const int K = g.K, nt = K / BK;
    unsigned voffA[2], voffB[2];
#pragma unroll
    for (int i = 0; i < 2; ++i) { int R, C; stage_rc(tid * 16 + i * 8192, R, C); const int Rb = Epi::PERM ? ((R & ~31) + perm32(R & 31)) : R;
        voffA[i] = (unsigned)(R * K + C) * 2u; voffB[i] = (unsigned)(Rb * K + C) * 2u; }
    const size_t kstep = (size_t)(BK * 2);
    const size_t hstep = (size_t)HALF * K * 2;
    const size_t tstep = 2 * hstep;
    const unsigned ldsw = (unsigned)wid * 1024u;
    const int aoff = lds_byte(wr * 64 + fr, fq * 8), boff = lds_byte(wc * 32 + fr, fq * 8);
#define PG8_SA(b, h) (((b) * 2 + (h)) * HTB)
#define PG8_SB(b, h) ((4 + (b) * 2 + (h)) * HTB)
#define PG8_STAGE(bufoff, gbase, voff) do { _Pragma("unroll") for (int _i = 0; _i < 2; ++_i) \
        __builtin_amdgcn_global_load_lds((const unsigned*)((const char*)(gbase) + (voff)[_i]), (LAS unsigned*)(lds + (bufoff) + ldsw + _i * 8192), 16, 0, 0); } while (0)
#define PG8_LDA(dst, b, h) do { _Pragma("unroll") for (int m = 0; m < 4; ++m) _Pragma("unroll") for (int k = 0; k < 2; ++k) dst[m][k] = *(const LAS bf16x8*)(lds + PG8_SA(b, h) + aoff + m * 2048 + k * 1024); } while (0)
#define PG8_LDB(dst, b, h) do { _Pragma("unroll") for (int n = 0; n < 2; ++n) _Pragma("unroll") for (int k = 0; k < 2; ++k) dst[n][k] = *(const LAS bf16x8*)(lds + PG8_SB(b, h) + boff + n * 2048 + k * 1024); } while (0)
#define PG8_MMA(ai, bj, At, Bt) do { __builtin_amdgcn_s_setprio(1); _Pragma("unroll") for (int m = 0; m < 4; ++m) _Pragma("unroll") for (int n = 0; n < 2; ++n) _Pragma("unroll") for (int k = 0; k < 2; ++k) \
        acc[ai][bj][m][n] = __builtin_amdgcn_mfma_f32_16x16x32_bf16(Bt[n][k], At[m][k], acc[ai][bj][m][n], 0, 0, 0); __builtin_amdgcn_s_setprio(0); } while (0)
#define PG8_WAIT_V(n) asm volatile("s_waitcnt vmcnt(" #n ")" ::: "memory")
#define PG8_WAIT_L(n) asm volatile("s_waitcnt lgkmcnt(" #n ")" ::: "memory")
#define PG8_BAR __builtin_amdgcn_s_barrier()
#define PG8_SCHED __builtin_amdgcn_sched_barrier(0)
    Unit cur, nxt; int ui = 0;
    if (!S.next(0, cur)) return;
    typename Epi::Pre pre_cur = E.pre(cur, wr, fr), pre_nxt = pre_cur;
    f32x4 acc[2][2][4][2];
#pragma unroll
    for (int a = 0; a < 2; ++a)
#pragma unroll
        for (int b = 0; b < 2; ++b)
#pragma unroll
            for (int m = 0; m < 4; ++m)
#pragma unroll
                for (int n = 0; n < 2; ++n) acc[a][b][m][n] = (f32x4){0.f, 0.f, 0.f, 0.f};
    bf16x8 At[4][2], B0[2][2], B1[2][2];
    const char* cA = (const char*)g.A + (size_t)cur.pm * tstep; const char* cB = (const char*)g.Bt + (size_t)cur.pn * tstep;
    S.a_ready(cur);
    if constexpr (SP2) {
        PG8_STAGE(PG8_SB(0, 0), cB, voffB); PG8_STAGE(PG8_SB(0, 1), cB + hstep, voffB); PG8_STAGE(PG8_SA(0, 0), cA, voffA); PG8_STAGE(PG8_SA(0, 1), cA + hstep, voffA);
        if (wr == 1) PG8_BAR;
        PG8_WAIT_V(2); PG8_BAR;
        PG8_STAGE(PG8_SB(1, 0), cB + kstep, voffB); PG8_STAGE(PG8_SA(1, 0), cA + kstep, voffA); PG8_STAGE(PG8_SB(1, 1), cB + hstep + kstep, voffB);
        PG8_WAIT_V(6); PG8_BAR;
    } else {
        PG8_STAGE(PG8_SB(0, 0), cB, voffB); PG8_STAGE(PG8_SA(0, 0), cA, voffA); PG8_STAGE(PG8_SB(0, 1), cB + hstep, voffB); PG8_STAGE(PG8_SA(0, 1), cA + hstep, voffA);
        if (wr == 1) PG8_BAR;
        PG8_WAIT_V(4); PG8_BAR;
        PG8_STAGE(PG8_SB(1, 0), cB + kstep, voffB); PG8_STAGE(PG8_SA(1, 0), cA + kstep, voffA); PG8_STAGE(PG8_SB(1, 1), cB + hstep + kstep, voffB);
        PG8_WAIT_V(6); PG8_BAR;
    }
    for (;;) {
        const bool has_next = S.next(ui + 1, nxt);
        const char* nA = has_next ? (const char*)g.A + (size_t)nxt.pm * tstep : cA; const char* nB = has_next ? (const char*)g.Bt + (size_t)nxt.pn * tstep : cB;
        for (int t = 0; t < nt; t += 2) {
            const bool last = (t == nt - 2);
            const char* a1 = cA + (size_t)(t + 1) * kstep;
            const char* a2 = last ? nA : cA + (size_t)(t + 2) * kstep; const char* b2 = last ? nB : cB + (size_t)(t + 2) * kstep;
            const char* a3 = a2 + kstep; const char* b3 = b2 + kstep;
            if (last && has_next) { S.a_ready(nxt); pre_nxt = E.pre(nxt, wr, fr); }
            if constexpr (SP2) {
            PG8_LDB(B0, 0, 0); PG8_LDB(B1, 0, 1); PG8_SCHED; PG8_LDA(At, 0, 0); PG8_STAGE(PG8_SA(1, 1), a1 + hstep, voffA);
            PG8_WAIT_V(8); PG8_WAIT_L(0); PG8_BAR; PG8_MMA(0, 0, At, B0); PG8_MMA(0, 1, At, B1); PG8_BAR; PG8_SCHED;
            PG8_LDA(At, 0, 1); PG8_STAGE(PG8_SB(0, 0), b2, voffB); PG8_STAGE(PG8_SB(0, 1), b2 + hstep, voffB); PG8_STAGE(PG8_SA(0, 0), a2, voffA);
            PG8_WAIT_V(8); PG8_WAIT_L(0); PG8_BAR; PG8_MMA(1, 0, At, B0); PG8_MMA(1, 1, At, B1); PG8_BAR; PG8_SCHED;
            PG8_LDB(B0, 1, 0); PG8_LDB(B1, 1, 1); PG8_SCHED; PG8_LDA(At, 1, 0); PG8_STAGE(PG8_SA(0, 1), a2 + hstep, voffA);
            PG8_WAIT_V(8); PG8_WAIT_L(0); PG8_BAR; PG8_MMA(0, 0, At, B0); PG8_MMA(0, 1, At, B1); PG8_BAR; PG8_SCHED;
            PG8_LDA(At, 1, 1); PG8_STAGE(PG8_SB(1, 0), b3, voffB); PG8_STAGE(PG8_SB(1, 1), b3 + hstep, voffB); PG8_STAGE(PG8_SA(1, 0), a3, voffA);
            PG8_WAIT_V(8); PG8_WAIT_L(0); PG8_BAR; PG8_MMA(1, 0, At, B0); PG8_MMA(1, 1, At, B1); PG8_BAR; PG8_SCHED;
            } else {
            PG8_LDB(B0, 0, 0); PG8_SCHED; PG8_LDA(At, 0, 0); PG8_STAGE(PG8_SA(1, 1), a1 + hstep, voffA);
            PG8_WAIT_L(8); PG8_BAR; PG8_WAIT_L(0); PG8_MMA(0, 0, At, B0); PG8_BAR; PG8_SCHED;
            PG8_LDB(B1, 0, 1); PG8_STAGE(PG8_SB(0, 0), b2, voffB);
            PG8_BAR; PG8_WAIT_L(0); PG8_MMA(0, 1, At, B1); PG8_BAR;
            PG8_LDA(At, 0, 1); PG8_STAGE(PG8_SA(0, 0), a2, voffA);
            PG8_BAR; PG8_WAIT_L(0); PG8_MMA(1, 0, At, B0); PG8_BAR; PG8_SCHED;
            PG8_STAGE(PG8_SB(0, 1), b2 + hstep, voffB);
            PG8_WAIT_V(6); PG8_BAR; PG8_MMA(1, 1, At, B1); PG8_BAR;
            PG8_LDB(B0, 1, 0); PG8_SCHED; PG8_LDA(At, 1, 0); PG8_STAGE(PG8_SA(0, 1), a2 + hstep, voffA);
            PG8_WAIT_L(8); PG8_BAR; PG8_WAIT_L(0); PG8_MMA(0, 0, At, B0); PG8_BAR; PG8_SCHED;
            PG8_LDB(B1, 1, 1); PG8_STAGE(PG8_SB(1, 0), b3, voffB);
            PG8_BAR; PG8_WAIT_L(0); PG8_MMA(0, 1, At, B1); PG8_BAR;
            PG8_LDA(At, 1, 1); PG8_STAGE(PG8_SA(1, 0), a3, voffA);
            PG8_BAR; PG8_WAIT_L(0); PG8_MMA(1, 0, At, B0); PG8_BAR; PG8_SCHED;
            PG8_STAGE(PG8_SB(1, 1), b3 + hstep, voffB);
            PG8_WAIT_V(6); PG8_BAR; PG8_MMA(1, 1, At, B1); PG8_BAR;
            }
        }
        if constexpr (ALIGN_EPI) { if (wr == 0) PG8_BAR; }
        E(acc, cur, wr, wc, fr, fq, pre_cur); S.done(cur);
        if (!has_next) break;
        pre_cur = pre_nxt;
#pragma unroll
        for (int a = 0; a < 2; ++a)
#pragma unroll
            for (int b = 0; b < 2; ++b)
#pragma unroll
                for (int m = 0; m < 4; ++m)
#pragma unroll
                    for (int n = 0; n < 2; ++n) acc[a][b][m][n] = (f32x4){0.f, 0.f, 0.f, 0.f};
        cur = nxt; cA = nA; cB = nB; ++ui;
        if constexpr (ALIGN_EPI) { if (wr == 1) PG8_BAR; }
    }
    PG8_WAIT_V(0);
    if constexpr (!ALIGN_EPI) { if (wr == 0) PG8_BAR; }
    PG8_BAR;
#undef PG8_SA
#undef PG8_SB
#undef PG8_STAGE
#undef PG8_LDA
#undef PG8_LDB
#undef PG8_MMA
#undef PG8_WAIT_V
#undef PG8_WAIT_L
#undef PG8_BAR
#undef PG8_SCHED
}

__device__ __forceinline__ float silu_mul(float g, float u) { return g * u * __builtin_amdgcn_rcpf(1.0f + __builtin_amdgcn_exp2f(-1.4426950408889634f * g)); }

struct PreNone {};
struct PreRows { float v[8]; };
__device__ __forceinline__ PreRows load_rows8(const float* ss, const Unit& u, int wr, int fr) {
    PreRows p; const float* b = ss + u.pm * BM + wr * 64 + fr;
#pragma unroll
    for (int ai = 0; ai < 2; ++ai)
#pragma unroll
        for (int m = 0; m < 4; ++m) p.v[ai * 4 + m] = b[ai * HALF + m * 16];
    return p;
}
struct EpiSwiglu {
    static constexpr bool PERM = true;
    typedef PreRows Pre;
    bf16_t* O; const float* ss;
    __device__ __forceinline__ Pre pre(const Unit& u, int wr, int fr) const { return load_rows8(ss, u, wr, fr); }
    __device__ __forceinline__ void operator()(const f32x4 (&acc)[2][2][4][2], const Unit& u, int wr, int wc, int fr, int fq, const Pre& pr) const {
        const int row0 = u.pm * BM + wr * 64 + fr, col0 = u.pn * HALF + wc * 32 + 8 * fq;
#pragma unroll
        for (int ai = 0; ai < 2; ++ai)
#pragma unroll
            for (int m = 0; m < 4; ++m) {
                const int row = row0 + ai * HALF + m * 16;
                const float rs = __builtin_amdgcn_rsqf(pr.v[ai * 4 + m] * (1.0f / D) + EPS);
                const f32x4 g0 = acc[ai][0][m][0] * rs, g1 = acc[ai][0][m][1] * rs, u0 = acc[ai][1][m][0] * rs, u1 = acc[ai][1][m][1] * rs;
                u32x4 w;
                w.x = cvt_pk_bf16(silu_mul(g0[0], u0[0]), silu_mul(g0[1], u0[1])); w.y = cvt_pk_bf16(silu_mul(g0[2], u0[2]), silu_mul(g0[3], u0[3]));
                w.z = cvt_pk_bf16(silu_mul(g1[0], u1[0]), silu_mul(g1[1], u1[1])); w.w = cvt_pk_bf16(silu_mul(g1[2], u1[2]), silu_mul(g1[3], u1[3]));
                *(u32x4*)(O + (size_t)row * FF + col0) = w;
            }
    }
};

template <bool BASE_BF16> struct EpiResid {
    static constexpr bool PERM = true;
    typedef PreNone Pre;
    const float* basef; const bf16_t* baseb; bf16_t* xb; float* ss; float alpha;
    __device__ __forceinline__ Pre pre(const Unit&, int, int) const { return Pre{}; }
    struct Row { f32x4 f[2][2]; u32x4 h[2]; };
    __device__ __forceinline__ void load(Row& r, size_t off) const {
#pragma unroll
        for (int bj = 0; bj < 2; ++bj) {
            if (BASE_BF16) r.h[bj] = *(const u32x4*)(baseb + off + bj * HALF);
            else { r.f[bj][0] = *(const f32x4*)(basef + off + bj * HALF); r.f[bj][1] = *(const f32x4*)(basef + off + bj * HALF + 4); } }
    }
    __device__ __forceinline__ void row(const Row& r, const f32x4 (&a)[2][2][4][2], int ai, int m, int row_, int col0, int fq) const {
        const size_t off = (size_t)row_ * D + col0; float sq = 0.f;
#pragma unroll
        for (int bj = 0; bj < 2; ++bj) {
            f32x4 b0, b1;
            if (BASE_BF16) { const u32x4 h = r.h[bj];
                b0 = (f32x4){__builtin_bit_cast(float, h[0] << 16), __builtin_bit_cast(float, h[0] & 0xffff0000u), __builtin_bit_cast(float, h[1] << 16), __builtin_bit_cast(float, h[1] & 0xffff0000u)};
                b1 = (f32x4){__builtin_bit_cast(float, h[2] << 16), __builtin_bit_cast(float, h[2] & 0xffff0000u), __builtin_bit_cast(float, h[3] << 16), __builtin_bit_cast(float, h[3] & 0xffff0000u)}; }
            else { b0 = r.f[bj][0]; b1 = r.f[bj][1]; }
            const f32x4 v0 = b0 + a[ai][bj][m][0] * alpha, v1 = b1 + a[ai][bj][m][1] * alpha;
            u32x4 w; w.x = cvt_pk_bf16(v0[0], v0[1]); w.y = cvt_pk_bf16(v0[2], v0[3]); w.z = cvt_pk_bf16(v1[0], v1[1]); w.w = cvt_pk_bf16(v1[2], v1[3]);
            *(u32x4*)(xb + off + bj * HALF) = w;
            sq += (v0[0] * v0[0] + v0[1] * v0[1]) + (v0[2] * v0[2] + v0[3] * v0[3]) + (v1[0] * v1[0] + v1[1] * v1[1]) + (v1[2] * v1[2] + v1[3] * v1[3]);
        }
        sq += __shfl_xor(sq, 16); sq += __shfl_xor(sq, 32);
        if (fq == 0) unsafeAtomicAdd(ss + row_, sq);
    }
    __device__ __forceinline__ void operator()(const f32x4 (&acc)[2][2][4][2], const Unit& u, int wr, int wc, int fr, int fq, const Pre&) const {
        const int row0 = u.pm * BM + wr * 64 + fr, col0 = u.pn * BM + wc * 32 + 8 * fq;
        Row pre[4];
#pragma unroll
        for (int m = 0; m < 4; ++m) load(pre[m], (size_t)(row0 + m * 16) * D + col0);
        asm volatile("" ::: "memory");
#pragma unroll
        for (int m = 0; m < 4; ++m) {
            row(pre[m], acc, 0, m, row0 + m * 16, col0, fq);
            load(pre[m], (size_t)(row0 + HALF + m * 16) * D + col0);
            asm volatile("" ::: "memory");
        }
#pragma unroll
        for (int m = 0; m < 4; ++m) { row(pre[m], acc, 1, m, row0 + HALF + m * 16, col0, fq); asm volatile("" ::: "memory"); }
    }
};

__device__ const float INVF[16] = {1.000000000e+00f, 4.403665960e-01f, 1.939227432e-01f, 8.539710194e-02f, 3.760603070e-02f, 1.656044088e-02f, 7.292664610e-03f, 3.211446106e-03f,
                                   1.414213562e-03f, 6.227724371e-04f, 2.742481884e-04f, 1.207697351e-04f, 5.318295734e-05f, 2.341999971e-05f, 1.031338525e-05f, 4.541670478e-06f};

struct EpiInProj {
    static constexpr bool PERM = false;
    typedef PreRows Pre;
    bf16_t* QKU; const float* ss; const int* pos; float* kmean;
    __device__ __forceinline__ Pre pre(const Unit& u, int wr, int fr) const { return load_rows8(ss, u, wr, fr); }
    __device__ __forceinline__ void operator()(f32x4 (&acc)[2][2][4][2], const Unit& u, int wr, int wc, int fr, int fq, const Pre& pr) const {
        const int row0 = u.pm * BM + wr * 64 + fr;
        const int kind = u.pn >> 2;
        const int ct = (u.pn & 3) * BM + wc * 32 + 4 * fq;
        bf16_t* dst = QKU + (size_t)kind * ((size_t)M * AW);
        float invf[4];
#pragma unroll
        for (int j = 0; j < 4; ++j) invf[j] = INVF[4 * fq + j];
#pragma unroll
        for (int ai = 0; ai < 2; ++ai)
#pragma unroll
            for (int m = 0; m < 4; ++m) {
                const int row = row0 + ai * HALF + m * 16;
                const float rs = __builtin_amdgcn_rsqf(pr.v[ai * 4 + m] * (1.0f / D) + EPS);
#pragma unroll
                for (int bj = 0; bj < 2; ++bj)
#pragma unroll
                    for (int n = 0; n < 2; ++n) acc[ai][bj][m][n] = acc[ai][bj][m][n] * rs;
                if (kind < 2 && wc == 0) {
                    const float p = (float)pos[row];
#pragma unroll
                    for (int j = 0; j < 4; ++j) {
                        const float ang = p * invf[j];
                        double rev = (double)ang * 0.15915494309189535; rev -= __builtin_floor(rev);
                        const float fr_ = (float)rev;
                        const float sn = __builtin_amdgcn_sinf(fr_), cs = __builtin_amdgcn_cosf(fr_);
#pragma unroll
                        for (int bj = 0; bj < 2; ++bj) { const float x1 = acc[ai][bj][m][0][j], x2 = acc[ai][bj][m][1][j];
                            acc[ai][bj][m][0][j] = x1 * cs - x2 * sn; acc[ai][bj][m][1][j] = x2 * cs + x1 * sn; }
                    }
                }
                const float qs = (kind == 0) ? QSCALE : 1.0f;
#pragma unroll
                for (int bj = 0; bj < 2; ++bj)
#pragma unroll
                    for (int n = 0; n < 2; ++n) { const f32x4 v = acc[ai][bj][m][n] * qs; u32x2 w; w.x = cvt_pk_bf16(v[0], v[1]); w.y = cvt_pk_bf16(v[2], v[3]);
                        *(u32x2*)(dst + (size_t)row * AW + ct + bj * HALF + n * 16) = w; }
            }
        if (kind == 1) {
            const int b = u.pm >> 4, blk = u.pm & 15;
#pragma unroll
            for (int bj = 0; bj < 2; ++bj)
#pragma unroll
                for (int n = 0; n < 2; ++n) {
                    f32x4 s = (f32x4){0.f, 0.f, 0.f, 0.f};
#pragma unroll
                    for (int ai = 0; ai < 2; ++ai)
#pragma unroll
                        for (int m = 0; m < 4; ++m) s += acc[ai][bj][m][n];
#pragma unroll
                    for (int j = 0; j < 4; ++j) { float v = s[j]; v += __shfl_xor(v, 1); v += __shfl_xor(v, 2); v += __shfl_xor(v, 4); v += __shfl_xor(v, 8); s[j] = v; }
                    if (fr == 0) { const int h = (u.pn & 3) * 2 + bj; float* km = kmean + ((size_t)((b * NH + h) * 16 + blk)) * HD + wc * 32 + n * 16 + 4 * fq;
#pragma unroll
                        for (int j = 0; j < 4; ++j) unsafeAtomicAdd(km + j, s[j] * (1.0f / 256.0f)); }
                }
        }
    }
};

struct EpiVT {
    static constexpr bool PERM = true;
    typedef PreNone Pre;
    bf16_t* VT; const float* ss;
    __device__ __forceinline__ Pre pre(const Unit&, int, int) const { return Pre{}; }
    __device__ __forceinline__ void operator()(const f32x4 (&acc)[2][2][4][2], const Unit& u, int wr, int wc, int fr, int fq, const Pre&) const {
        const int row0 = u.pm * BM + wr * 64 + fr, col0 = u.pn * BM + wc * 32 + 8 * fq;
        f32x4 rs[2][2];
#pragma unroll
        for (int bj = 0; bj < 2; ++bj)
#pragma unroll
            for (int n = 0; n < 2; ++n) { const f32x4 s = *(const f32x4*)(ss + col0 + bj * HALF + 4 * n);
#pragma unroll
                for (int j = 0; j < 4; ++j) rs[bj][n][j] = __builtin_amdgcn_rsqf(s[j] * (1.0f / D) + EPS); }
#pragma unroll
        for (int ai = 0; ai < 2; ++ai)
#pragma unroll
            for (int m = 0; m < 4; ++m) {
                const int row = row0 + ai * HALF + m * 16;
#pragma unroll
                for (int bj = 0; bj < 2; ++bj) { const f32x4 v0 = acc[ai][bj][m][0] * rs[bj][0], v1 = acc[ai][bj][m][1] * rs[bj][1];
                    u32x4 w; w.x = cvt_pk_bf16(v0[0], v0[1]); w.y = cvt_pk_bf16(v0[2], v0[3]); w.z = cvt_pk_bf16(v1[0], v1[1]); w.w = cvt_pk_bf16(v1[2], v1[3]);
                    *(u32x4*)(VT + (size_t)row * M + col0 + bj * HALF) = w; }
            }
    }
};

struct EpiPool {
    static constexpr bool PERM = true;
    typedef PreNone Pre;
    bf16_t* MIX; const float* pscale;
    __device__ __forceinline__ Pre pre(const Unit&, int, int) const { return Pre{}; }
    __device__ __forceinline__ void operator()(const f32x4 (&acc)[2][2][4][2], const Unit& u, int wr, int wc, int fr, int fq, const Pre&) const {
        const int g = u.pn; const int row0 = (u.pm - 64 * g) * BM + wr * 64 + fr, col0 = g * BM + wc * 32 + 8 * fq;
        f32x4 sc[2][2];
#pragma unroll
        for (int bj = 0; bj < 2; ++bj)
#pragma unroll
            for (int n = 0; n < 2; ++n) sc[bj][n] = *(const f32x4*)(pscale + col0 + bj * HALF + 4 * n);
#pragma unroll
        for (int ai = 0; ai < 2; ++ai)
#pragma unroll
            for (int m = 0; m < 4; ++m) {
                const int row = row0 + ai * HALF + m * 16;
#pragma unroll
                for (int bj = 0; bj < 2; ++bj) { const f32x4 v0 = acc[ai][bj][m][0] * sc[bj][0], v1 = acc[ai][bj][m][1] * sc[bj][1];
                    u32x4 w; w.x = cvt_pk_bf16(v0[0], v0[1]); w.y = cvt_pk_bf16(v0[2], v0[3]); w.z = cvt_pk_bf16(v1[0], v1[1]); w.w = cvt_pk_bf16(v1[2], v1[3]);
                    *(u32x4*)(MIX + (size_t)row * D + AW + col0 + bj * HALF) = w; }
            }
    }
};
}

namespace att {
constexpr int KROW = 272, VROW = 272, KT = 128 * KROW, VT_B = 128 * VROW;
constexpr int OFF_K = 0, OFF_V = 2 * KT, OFF_WS = 2 * KT + 2 * VT_B, LDS_NEED = OFF_WS + 8 * 256;

__device__ __forceinline__ int crow(int r, int hi) { return (r & 3) + 8 * (r >> 2) + 4 * hi; }

__device__ __forceinline__ void attn_unit(int b, int h, int qb, const bf16_t* __restrict__ Q, const bf16_t* __restrict__ K, const bf16_t* __restrict__ VT, const float* __restrict__ kmean,
                                          bf16_t* __restrict__ O, LAS unsigned char* lds) {
    int tid = threadIdx.x; asm volatile("" : "+v"(tid));
    const int lane = tid & 63, r32 = lane & 31, hi = lane >> 5; const int wid = __builtin_amdgcn_readfirstlane(tid >> 6);
    const size_t rowbase = (size_t)b * SEQ; const int q0 = qb * 256;
    const bf16_t* Qw = Q + (rowbase + q0 + wid * 32 + r32) * AW + h * HD + hi * 8;
    bf16x8 qf[8];
#pragma unroll
    for (int d0 = 0; d0 < 8; ++d0) qf[d0] = *(const bf16x8*)(Qw + d0 * 16);
    const bf16_t* gK = K + (rowbase + (tid >> 4)) * AW + h * HD + (tid & 15) * 8;
    const bf16_t* gV = VT + (size_t)(h * HD + (tid >> 4)) * M + rowbase + (tid & 15) * 8;
    const int lK = OFF_K + (tid >> 4) * KROW + (tid & 15) * 16, lV = OFF_V + (tid >> 4) * VROW + (tid & 15) * 16;
    const int pi32 = (r32 & 0x13) | ((r32 & 4) << 1) | ((r32 & 8) >> 1);
    const int kread = OFF_K + pi32 * KROW + hi * 16, vread = OFF_V + r32 * VROW + hi * 16;
    LAS float* wsf = (LAS float*)(lds + OFF_WS + wid * 256);
    const int NS = 2 * (qb + 1);
    LAS float* kml = (LAS float*)(lds + OFF_K + KT);
    f32x4 kmv = (f32x4){0.f, 0.f, 0.f, 0.f};
    if (tid < qb * 32) kmv = *(const f32x4*)(kmean + (size_t)((b * NH + h) * 16) * HD + tid * 4);
    u32x4 kr[4], vr[4];
#pragma unroll
    for (int i = 0; i < 4; ++i) { kr[i] = *(const u32x4*)(gK + (size_t)i * 32 * AW); vr[i] = *(const u32x4*)(gV + (size_t)i * 32 * M); }
    if (tid < qb * 32) *(LAS f32x4*)(kml + tid * 4) = kmv;
    __syncthreads();
    unsigned mask = 1u << qb;
    {
        float v1 = -3.0e38f, v2 = -3.0e38f, v3 = -3.0e38f; int i1 = -1, i2 = -1, i3 = -1;
        const LAS float* km = kml + hi * 8;
        for (int j = 0; j < qb; ++j) {
            float g = 0.f;
#pragma unroll
            for (int d0 = 0; d0 < 8; ++d0) { const f32x4 a = *(const LAS f32x4*)(km + j * HD + d0 * 16), c = *(const LAS f32x4*)(km + j * HD + d0 * 16 + 4);
                g += bf2f((unsigned short)qf[d0][0]) * a[0] + bf2f((unsigned short)qf[d0][1]) * a[1] + bf2f((unsigned short)qf[d0][2]) * a[2] + bf2f((unsigned short)qf[d0][3]) * a[3]
                   + bf2f((unsigned short)qf[d0][4]) * c[0] + bf2f((unsigned short)qf[d0][5]) * c[1] + bf2f((unsigned short)qf[d0][6]) * c[2] + bf2f((unsigned short)qf[d0][7]) * c[3]; }
            g += __shfl_xor(g, 32);
            if (g > v1) { v3 = v2; i3 = i2; v2 = v1; i2 = i1; v1 = g; i1 = j; }
            else if (g > v2) { v3 = v2; i3 = i2; v2 = g; i2 = j; }
            else if (g > v3) { v3 = g; i3 = j; }
        }
        if (i1 >= 0) mask |= 1u << i1; if (i2 >= 0) mask |= 1u << i2; if (i3 >= 0) mask |= 1u << i3;
    }
    unsigned wmask = 0;
    for (int j = 0; j <= qb; ++j) if (__any((int)((mask >> j) & 1u))) wmask |= 1u << j;
    wmask = __builtin_amdgcn_readfirstlane(wmask);
#pragma unroll
    for (int i = 0; i < 4; ++i) { *(LAS u32x4*)(lds + lK + i * 32 * KROW) = kr[i]; *(LAS u32x4*)(lds + lV + i * 32 * VROW) = vr[i]; }
    __syncthreads();
    float mrun = NEGBIG, lrun = 0.f;
    f32x16 o[4];
#pragma unroll
    for (int d = 0; d < 4; ++d)
#pragma unroll
        for (int r = 0; r < 16; ++r) o[d][r] = 0.f;
    const int qrel = wid * 32 + r32;
    for (int S = 0; S < NS; ++S) {
        const int cur = S & 1, j = S >> 1;
        if (S + 1 < NS) {
#pragma unroll
            for (int i = 0; i < 4; ++i) { kr[i] = *(const u32x4*)(gK + ((size_t)(S + 1) * 128 + i * 32) * AW); vr[i] = *(const u32x4*)(gV + (size_t)i * 32 * M + (S + 1) * 128); }
        }
        if ((wmask >> j) & 1u) {
#pragma unroll 1
          for (int u = 0; u < 2; ++u) {
            const int t = 2 * (S & 1) + u;
            if (j == qb && 64 * t > 32 * wid + 31) break;
            f32x16 p0, p1;
#pragma unroll
            for (int r = 0; r < 16; ++r) { p0[r] = 0.f; p1[r] = 0.f; }
            const LAS unsigned char* kb = lds + kread + cur * KT + u * 64 * KROW;
            const LAS unsigned char* vb = lds + vread + cur * VT_B + u * 128;
            bf16x8 ka[2][4];
#define ATT_LDK(B, G) do { ka[B][0] = *(const LAS bf16x8*)(kb + (2 * (G)) * 32); ka[B][1] = *(const LAS bf16x8*)(kb + 32 * KROW + (2 * (G)) * 32); \
                           ka[B][2] = *(const LAS bf16x8*)(kb + (2 * (G) + 1) * 32); ka[B][3] = *(const LAS bf16x8*)(kb + 32 * KROW + (2 * (G) + 1) * 32); } while (0)
            ATT_LDK(0, 0);
#pragma unroll
            for (int g = 0; g < 4; ++g) {
                if (g < 3) ATT_LDK((g + 1) & 1, g + 1);
                __builtin_amdgcn_sched_barrier(0);
                p0 = __builtin_amdgcn_mfma_f32_32x32x16_bf16(ka[g & 1][0], qf[2 * g], p0, 0, 0, 0);
                p1 = __builtin_amdgcn_mfma_f32_32x32x16_bf16(ka[g & 1][1], qf[2 * g], p1, 0, 0, 0);
                p0 = __builtin_amdgcn_mfma_f32_32x32x16_bf16(ka[g & 1][2], qf[2 * g + 1], p0, 0, 0, 0);
                p1 = __builtin_amdgcn_mfma_f32_32x32x16_bf16(ka[g & 1][3], qf[2 * g + 1], p1, 0, 0, 0);
                __builtin_amdgcn_sched_barrier(0);
            }
#undef ATT_LDK
            bf16x8 va[2][4];
#define ATT_LDV(B, C) do { _Pragma("unroll") for (int d = 0; d < 4; ++d) va[B][d] = *(const LAS bf16x8*)(vb + d * 32 * VROW + (C) * 32); } while (0)
            ATT_LDV(0, 0);
            __builtin_amdgcn_sched_barrier(0);
            const bool rowsel = (mask >> j) & 1u;
            if (j == qb) {
                const int kvb = 64 * t + 8 * hi;
#pragma unroll
                for (int r = 0; r < 16; ++r) { const int kv = kvb + 16 * (r >> 3) + (r & 7); if (kv > qrel) p0[r] = NEGBIG; if (kv + 32 > qrel) p1[r] = NEGBIG; }
            }
            float rm = fmaxf(p0[0], p1[0]);
#pragma unroll
            for (int r = 1; r < 16; ++r) rm = fmaxf(rm, fmaxf(p0[r], p1[r]));
            { const auto rr = __builtin_amdgcn_permlane32_swap(__float_as_uint(rm), __float_as_uint(rm), false, false); rm = fmaxf(__uint_as_float(rr[0]), __uint_as_float(rr[1])); }
            rm = rowsel ? rm : NEGBIG;
            const bool grow = rm > mrun + 8.0f;
            const float mnew = grow ? rm : mrun;
            const float alpha = grow ? __builtin_amdgcn_exp2f(mrun - mnew) : 1.0f;
            mrun = mnew;
            const float msub = rowsel ? mnew : 1e30f;
            float sum = 0.f;
#pragma unroll
            for (int r = 0; r < 16; ++r) { p0[r] = __builtin_amdgcn_exp2f(p0[r] - msub); p1[r] = __builtin_amdgcn_exp2f(p1[r] - msub); sum += p0[r] + p1[r]; }
            lrun = lrun * alpha + sum;
            if (__any(grow)) {
                if (hi == 0) wsf[r32] = alpha;
                asm volatile("s_waitcnt lgkmcnt(0)" ::: "memory");
#pragma unroll
                for (int gq = 0; gq < 4; ++gq) { const f32x4 a = *(const LAS f32x4*)(wsf + 8 * gq + 4 * hi);
#pragma unroll
                    for (int d = 0; d < 4; ++d) { o[d][4 * gq + 0] *= a[0]; o[d][4 * gq + 1] *= a[1]; o[d][4 * gq + 2] *= a[2]; o[d][4 * gq + 3] *= a[3]; } }
                asm volatile("s_waitcnt lgkmcnt(0)" ::: "memory");
            }
            bf16x8 pw[4];
            { u32x4 w;
              w.x = cvt_pk_bf16(p0[0], p0[1]); w.y = cvt_pk_bf16(p0[2], p0[3]); w.z = cvt_pk_bf16(p0[4], p0[5]); w.w = cvt_pk_bf16(p0[6], p0[7]); pw[0] = __builtin_bit_cast(bf16x8, w);
              w.x = cvt_pk_bf16(p0[8], p0[9]); w.y = cvt_pk_bf16(p0[10], p0[11]); w.z = cvt_pk_bf16(p0[12], p0[13]); w.w = cvt_pk_bf16(p0[14], p0[15]); pw[1] = __builtin_bit_cast(bf16x8, w);
              w.x = cvt_pk_bf16(p1[0], p1[1]); w.y = cvt_pk_bf16(p1[2], p1[3]); w.z = cvt_pk_bf16(p1[4], p1[5]); w.w = cvt_pk_bf16(p1[6], p1[7]); pw[2] = __builtin_bit_cast(bf16x8, w);
              w.x = cvt_pk_bf16(p1[8], p1[9]); w.y = cvt_pk_bf16(p1[10], p1[11]); w.z = cvt_pk_bf16(p1[12], p1[13]); w.w = cvt_pk_bf16(p1[14], p1[15]); pw[3] = __builtin_bit_cast(bf16x8, w); }
            __builtin_amdgcn_sched_barrier(0);
#pragma unroll
            for (int c = 0; c < 4; ++c) {
                if (c < 3) ATT_LDV((c + 1) & 1, c + 1);
                __builtin_amdgcn_sched_barrier(0);
#pragma unroll
                for (int d = 0; d < 4; ++d) o[d] = __builtin_amdgcn_mfma_f32_32x32x16_bf16(pw[c], va[c & 1][d], o[d], 0, 0, 0);
                __builtin_amdgcn_sched_barrier(0);
            }
#undef ATT_LDV
          }
        }
        if (S + 1 < NS) {
            const int nb = cur ^ 1;
#pragma unroll
            for (int i = 0; i < 4; ++i) { *(LAS u32x4*)(lds + lK + nb * KT + i * 32 * KROW) = kr[i]; *(LAS u32x4*)(lds + lV + nb * VT_B + i * 32 * VROW) = vr[i]; }
        }
        __syncthreads();
    }
    lrun += __shfl_xor(lrun, 32);
    const float inv = 1.0f / lrun;
    if (hi == 0) wsf[r32] = inv;
    asm volatile("s_waitcnt lgkmcnt(0)" ::: "memory");
    bf16_t* Ow = O + (rowbase + q0 + wid * 32) * D + h * HD + r32;
#pragma unroll
    for (int gq = 0; gq < 4; ++gq) { const f32x4 a = *(const LAS f32x4*)(wsf + 8 * gq + 4 * hi);
#pragma unroll
        for (int jj = 0; jj < 4; ++jj) { const int r = 4 * gq + jj; const int orow = crow(r, hi);
#pragma unroll
            for (int d = 0; d < 4; ++d) { const unsigned w = cvt_pk_bf16(o[d][r] * a[jj], 0.f); Ow[(size_t)orow * D + d * 32] = (bf16_t)(w & 0xffffu); } } }
    asm volatile("s_waitcnt lgkmcnt(0)" ::: "memory");
    __syncthreads();
}
}


#define XB_TMO      128
#define XB_XCNT(j)  (256  + 64 * (j))
#define XB_XSUB(j)  (1280 + 64 * (j))
#define XB_XGEN(j)  (2304 + 64 * (j))
#define XB_TOP      3328
#define XB_TOPGEN   3392
#define XCD_BAR_WORDS 3456
#define XB_SPIN_CAP (1u << 18)
__device__ __forceinline__ unsigned xb_ld(unsigned* p)              { return __hip_atomic_load(p, __ATOMIC_RELAXED, __HIP_MEMORY_SCOPE_AGENT); }
__device__ __forceinline__ unsigned xb_add(unsigned* p, unsigned v) { return __hip_atomic_fetch_add(p, v, __ATOMIC_RELAXED, __HIP_MEMORY_SCOPE_AGENT); }
__device__ __forceinline__ unsigned xb_xcc_id() { return (unsigned)__builtin_amdgcn_s_getreg((3 << 11) | 20) & 0xFu; }
#define XB_SPIN(cond, bar) do { unsigned _sp = 0; while (cond) { __builtin_amdgcn_s_sleep(1); \
    if ((++_sp & 255u) == 0u) { if (xb_ld(&(bar)[XB_TMO])) break; if (_sp > XB_SPIN_CAP) { atomicAdd(&(bar)[XB_TMO], 1u); break; } } } } while (0)
struct XcdBarrier { unsigned* bar; unsigned x; volatile LAS unsigned* st; };
__device__ __forceinline__ XcdBarrier xcd_barrier_post(unsigned* bar, volatile LAS unsigned* st) {
    XcdBarrier b; b.bar = bar; b.x = xb_xcc_id(); b.st = st;
    if (threadIdx.x == 0) (void)xb_add(&bar[XB_XCNT(b.x)], 1u);
    return b;
}
__device__ __forceinline__ void xcd_barrier_complete(unsigned* bar, unsigned x, unsigned& nloc, unsigned& nx) {
    const unsigned G = gridDim.x * gridDim.y * gridDim.z;
    unsigned sum, cnt, mine, sp = 0u;
    for (;;) {
        sum = 0u; cnt = 0u; mine = 0u;
#pragma unroll
        for (unsigned j = 0; j < 16; ++j) { const unsigned c = xb_ld(&bar[XB_XCNT(j)]); sum += c; cnt += (c > 0u) ? 1u : 0u; mine = (j == x) ? c : mine; }
        if (sum == G) break;
        __builtin_amdgcn_s_sleep(1);
        if ((++sp & 255u) == 0u) { if (xb_ld(&bar[XB_TMO])) break; if (sp > XB_SPIN_CAP) { atomicAdd(&bar[XB_TMO], 1u); break; } }
    }
    nloc = mine > 0u ? mine : 1u; nx = cnt > 0u ? cnt : 1u;
}
__device__ __forceinline__ void xcd_barrier(const XcdBarrier& b) {
    asm volatile("s_waitcnt vmcnt(0)" ::: "memory");
    __syncthreads();
    if (threadIdx.x == 0) {
        unsigned* bar = b.bar;
        __builtin_amdgcn_s_waitcnt(0);
        unsigned nloc = b.st[0], nx = b.st[1];
        if (nloc == 0u) { xcd_barrier_complete(bar, b.x, nloc, nx); b.st[0] = nloc; b.st[1] = nx; }
        const unsigned old = xb_add(&bar[XB_XSUB(b.x)], 1u);
        const unsigned gen = old / nloc;
        if (old + 1u == (gen + 1u) * nloc) {
            __builtin_amdgcn_fence(__ATOMIC_RELEASE, "agent");
            asm volatile("s_waitcnt vmcnt(0)" ::: "memory");
            const unsigned og = xb_add(&bar[XB_TOP], 1u);
            const unsigned tg = og / nx;
            if (og + 1u == (tg + 1u) * nx) xb_add(&bar[XB_TOPGEN], 1u);
            else XB_SPIN(xb_ld(&bar[XB_TOPGEN]) == tg, bar);
            __builtin_amdgcn_fence(__ATOMIC_ACQUIRE, "agent");
            xb_add(&bar[XB_XGEN(b.x)], 1u);
            asm volatile("s_waitcnt vmcnt(0)" ::: "memory");
        } else {
            XB_SPIN(xb_ld(&bar[XB_XGEN(b.x)]) == gen, bar);
            __builtin_amdgcn_fence(__ATOMIC_ACQUIRE, "agent");
            asm volatile("s_waitcnt vmcnt(0)" ::: "memory");
        }
    }
    __syncthreads();
}

constexpr int NWAVES = 8;
constexpr int LDS_BYTES = 147456, LDS_MISC = 147200;
constexpr size_t al256(size_t x) { return (x + 255) & ~(size_t)255; }
constexpr size_t WS_CTL = 0, CTL_BYTES = 16384;
constexpr size_t WS_SS = CTL_BYTES;
constexpr size_t WS_KMEAN = WS_SS + (size_t)4 * M * 4;
constexpr size_t WS_WGU1 = WS_KMEAN + (size_t)4 * NH * 16 * HD * 4;
constexpr size_t WS_WD1 = WS_WGU1 + (size_t)2 * FF * D * 2;
constexpr size_t WS_WIN = WS_WD1 + (size_t)D * FF * 2;
constexpr size_t WS_WPOOL = WS_WIN + (size_t)4096 * D * 2;
constexpr size_t WS_WOUT = WS_WPOOL + (size_t)1024 * 256 * 2;
constexpr size_t WS_WGU2 = WS_WOUT + (size_t)D * D * 2;
constexpr size_t WS_WD2 = WS_WGU2 + (size_t)2 * FF * D * 2;
constexpr size_t WS_XB = WS_WD2 + (size_t)D * FF * 2;
constexpr size_t WS_ACT = WS_XB + (size_t)M * D * 2;
constexpr size_t WS_Q = WS_ACT, WS_K = WS_Q + (size_t)M * AW * 2, WS_U = WS_K + (size_t)M * AW * 2, WS_VT = WS_U + (size_t)M * AW * 2, WS_PL = WS_VT + (size_t)M * AW * 2;
constexpr size_t WS_MIX = WS_ACT + (size_t)M * FF * 2;
constexpr size_t WS_END = WS_MIX + (size_t)M * D * 2;
static_assert(WS_PL + (size_t)M * AW * 2 <= WS_MIX, "overlay fits");

struct Args { const float* in[16]; float* out; unsigned char* ws; };

__device__ __forceinline__ float wave_sum(float v) {
#pragma unroll
    for (int o = 1; o < 64; o <<= 1) v += __shfl_xor(v, o);
    return v;
}
__device__ __forceinline__ void transpose_item(const float* __restrict__ W, int N, int k0, int n0, const float* __restrict__ gain, bf16_t* dst, int ldt, LAS float* scr, int lane) {
    f32x4 v[16];
    const int lr = lane >> 4, lc = 4 * (lane & 15);
#pragma unroll
    for (int i = 0; i < 16; ++i) v[i] = __builtin_nontemporal_load((const f32x4*)(W + (size_t)(k0 + 4 * i + lr) * N + n0 + lc));
    if (gain) {
#pragma unroll
        for (int i = 0; i < 16; ++i) v[i] = v[i] * gain[k0 + 4 * i + lr];
    }
#pragma unroll
    for (int i = 0; i < 16; ++i) { LAS float* d = scr + (4 * i + lr) * 65 + lc; d[0] = v[i][0]; d[1] = v[i][1]; d[2] = v[i][2]; d[3] = v[i][3]; }
    asm volatile("s_waitcnt lgkmcnt(0)" ::: "memory");
    const int c = lane >> 3, nl = lane & 7;
#pragma unroll
    for (int j = 0; j < 8; ++j) { const int n = nl + 8 * j; const LAS float* s = scr + (8 * c) * 65 + n;
        u32x4 o; o.x = cvt_pk_bf16(s[0 * 65], s[1 * 65]); o.y = cvt_pk_bf16(s[2 * 65], s[3 * 65]); o.z = cvt_pk_bf16(s[4 * 65], s[5 * 65]); o.w = cvt_pk_bf16(s[6 * 65], s[7 * 65]);
        *(u32x4*)(dst + (size_t)n * ldt + 8 * c) = o; }
    asm volatile("s_waitcnt lgkmcnt(0)" ::: "memory");
}
__device__ __forceinline__ int dest_row(int mode, int n) {
    if (mode == 1) return (n >> 7) * 256 + (n & 127);
    if (mode == 2) return (n >> 7) * 256 + 128 + (n & 127);
    if (mode == 3) return n < 2048 ? n : (n < 3072 ? n + 1024 : n - 1024);
    return n;
}
__device__ __forceinline__ void transpose_mat(const float* W, int K, int N, const float* gain, bf16_t* WT, int mode, int item, LAS float* scr, int lane) {
    const int nblk = N / 64, kb = item / nblk, nb = item % nblk;
    transpose_item(W, N, 64 * kb, 64 * nb, gain, WT + (size_t)dest_row(mode, 64 * nb) * K + 64 * kb, K, scr, lane);
}

template <int WIN> __device__ __forceinline__ void pooled_tile(const bf16_t* __restrict__ UB, bf16_t* __restrict__ PL, int g, int pm, int tidp) {
#pragma unroll 1
    for (int pass = 0; pass < 2; ++pass) {
        const int chunk = tidp & 31, seg = (tidp >> 5) + 16 * pass;
        const int r0 = pm * 256 + seg * 8, sq0 = r0 & (SEQ - 1);
        const bf16_t* up = UB + (size_t)r0 * AW + g * 256 + chunk * 8;
        u32x4 rows[7 + WIN];
#pragma unroll
        for (int k = 0; k < 7 + WIN; ++k) { const int rel = k - (WIN - 1);
            rows[k] = (sq0 + rel >= 0) ? *(const u32x4*)(up + (long)rel * AW) : (u32x4){0u, 0u, 0u, 0u}; }
        float sm[8];
#pragma unroll
        for (int j = 0; j < 8; ++j) sm[j] = 0.f;
#pragma unroll
        for (int k = 0; k < WIN; ++k)
#pragma unroll
            for (int j = 0; j < 4; ++j) { sm[2 * j] += __builtin_bit_cast(float, rows[k][j] << 16); sm[2 * j + 1] += __builtin_bit_cast(float, rows[k][j] & 0xffff0000u); }
#pragma unroll
        for (int i = 0; i < 8; ++i) {
            if (i > 0) {
#pragma unroll
                for (int j = 0; j < 4; ++j) {
                    sm[2 * j] += __builtin_bit_cast(float, rows[WIN - 1 + i][j] << 16) - __builtin_bit_cast(float, rows[i - 1][j] << 16);
                    sm[2 * j + 1] += __builtin_bit_cast(float, rows[WIN - 1 + i][j] & 0xffff0000u) - __builtin_bit_cast(float, rows[i - 1][j] & 0xffff0000u); }
            }
            const int c = sq0 + i + 1; const float ic = 1.0f / (float)(c < WIN ? c : WIN);
            const u32x4 self = rows[WIN - 1 + i]; u32x4 o;
#pragma unroll
            for (int j = 0; j < 4; ++j) o[j] = cvt_pk_bf16(sm[2 * j] * ic - __builtin_bit_cast(float, self[j] << 16), sm[2 * j + 1] * ic - __builtin_bit_cast(float, self[j] & 0xffff0000u));
            *(u32x4*)(PL + ((size_t)g * M + r0 + i) * 256 + chunk * 8) = o;
        }
    }
}

__global__ void __launch_bounds__(NWAVES * 64, 2) fwd_kernel(Args args) {
    extern __shared__ __attribute__((aligned(16))) unsigned char lds_raw[];
    LAS unsigned char* lds = (LAS unsigned char*)lds_raw;
    cg::grid_group grid = cg::this_grid();
    const int tid = threadIdx.x, lane = tid & 63; const int wave = __builtin_amdgcn_readfirstlane(tid >> 6);
    if (tid < 16) ((LAS unsigned*)(lds + LDS_MISC))[tid] = 0u;
    __syncthreads();
    const XcdBarrier xbar = xcd_barrier_post((unsigned*)(args.ws + WS_CTL), (volatile LAS unsigned*)(lds + LDS_MISC));
    if (args.ws == nullptr) grid.sync();
    const int G = gridDim.x, bx = blockIdx.x;
    const int vcu = (G % 8 == 0) ? (bx % 8) * (G / 8) + bx / 8 : bx;
    unsigned char* ws = args.ws;
    const float* x = args.in[0]; const int* pos = (const int*)args.in[1];
    const float *g_ffn1 = args.in[2], *w1g = args.in[3], *w1u = args.in[4], *w1d = args.in[5], *g_mix = args.in[6], *w_in = args.in[7], *pool_w = args.in[8], *pool_scale = args.in[9],
                *w_out = args.in[10], *g_ffn2 = args.in[11], *w2g = args.in[12], *w2u = args.in[13], *w2d = args.in[14], *g_fin = args.in[15];
    float* out = args.out;
    float* ss0 = (float*)(ws + WS_SS); float* ss1 = ss0 + M; float* ss2 = ss1 + M; float* ss3 = ss2 + M;
    float* kmean = (float*)(ws + WS_KMEAN);
    bf16_t *WGU1 = (bf16_t*)(ws + WS_WGU1), *WD1 = (bf16_t*)(ws + WS_WD1), *WIN = (bf16_t*)(ws + WS_WIN), *WPOOL = (bf16_t*)(ws + WS_WPOOL), *WOUT = (bf16_t*)(ws + WS_WOUT),
           *WGU2 = (bf16_t*)(ws + WS_WGU2), *WD2 = (bf16_t*)(ws + WS_WD2);
    bf16_t *XB = (bf16_t*)(ws + WS_XB), *ACT = (bf16_t*)(ws + WS_ACT), *QB = (bf16_t*)(ws + WS_Q), *KB = (bf16_t*)(ws + WS_K), *VTB = (bf16_t*)(ws + WS_VT), *UB = (bf16_t*)(ws + WS_U),
           *PL = (bf16_t*)(ws + WS_PL), *MIX = (bf16_t*)(ws + WS_MIX);
    const int gw = vcu * NWAVES + wave, NGW = G * NWAVES;
    const int gt = bx * (NWAVES * 64) + tid, NGT = G * NWAVES * 64;

    for (int rep = 0; rep < REP_P0; ++rep) {
        for (int i = gt; i < 3 * M; i += NGT) ss1[i] = 0.f;
        for (int i = gt; i < 4 * NH * 16 * HD; i += NGT) kmean[i] = 0.f;
        LAS float* scr = (LAS float*)(lds + wave * 16640);
        constexpr int I_GU = (D / 64) * (FF / 64), I_DN = (FF / 64) * (D / 64), I_IN = (D / 64) * (4096 / 64), I_PW = (256 / 64) * (256 / 64), I_OUT = (D / 64) * (D / 64);
        constexpr int NITEMS = 4 * I_GU + 2 * I_DN + I_IN + 4 * I_PW + I_OUT;
        for (int it = gw; it < NITEMS; it += NGW) {
            int r = it;
            if (r < I_GU) { transpose_mat(w1g, D, FF, g_ffn1, WGU1, 1, r, scr, lane); continue; } r -= I_GU;
            if (r < I_GU) { transpose_mat(w1u, D, FF, g_ffn1, WGU1, 2, r, scr, lane); continue; } r -= I_GU;
            if (r < I_DN) { transpose_mat(w1d, FF, D, nullptr, WD1, 0, r, scr, lane); continue; } r -= I_DN;
            if (r < I_IN) { transpose_mat(w_in, D, 4096, g_mix, WIN, 3, r, scr, lane); continue; } r -= I_IN;
            if (r < 4 * I_PW) { const int g = r / I_PW; transpose_mat(pool_w + (size_t)g * 65536, 256, 256, nullptr, WPOOL + (size_t)g * 65536, 0, r % I_PW, scr, lane); continue; } r -= 4 * I_PW;
            if (r < I_OUT) { transpose_mat(w_out, D, D, nullptr, WOUT, 0, r, scr, lane); continue; } r -= I_OUT;
            if (r < I_GU) { transpose_mat(w2g, D, FF, g_ffn2, WGU2, 1, r, scr, lane); continue; } r -= I_GU;
            if (r < I_GU) { transpose_mat(w2u, D, FF, g_ffn2, WGU2, 2, r, scr, lane); continue; } r -= I_GU;
            transpose_mat(w2d, FF, D, nullptr, WD2, 0, r, scr, lane);
        }
        for (int m = gw; m < M; m += NGW) {
            const f32x4* xr = (const f32x4*)(x + (size_t)m * D) + lane; float s = 0.f; f32x4 v[8];
#pragma unroll
            for (int j = 0; j < 8; ++j) { v[j] = __builtin_nontemporal_load(xr + 64 * j); s += (v[j][0] * v[j][0] + v[j][1] * v[j][1]) + (v[j][2] * v[j][2] + v[j][3] * v[j][3]); }
            s = wave_sum(s);
            u32x2* o8 = (u32x2*)(XB + (size_t)m * D) + lane;
#pragma unroll
            for (int j = 0; j < 8; ++j) { u32x2 w; w.x = cvt_pk_bf16(v[j][0], v[j][1]); w.y = cvt_pk_bf16(v[j][2], v[j][3]); o8[64 * j] = w; }
            if (lane == 0) ss0[m] = s;
        }
    }
    xcd_barrier(xbar);
    for (int rep = 0; rep < REP_P1; ++rep) { pg8::Gemm g{XB, WGU1, M, 2 * FF, D}; pg8::StaticOrder S; S.init(M, 2 * FF, G, bx); pg8::EpiSwiglu E{ACT, ss0};
      pg8::gemm_phase<pg8::EpiSwiglu, pg8::StaticOrder, true, true>(lds, g, S, E); }
    xcd_barrier(xbar);
    { pg8::Gemm g{ACT, WD1, M, D, FF}; pg8::StaticOrder S; S.init(M, D, G, bx); pg8::EpiResid<true> E{nullptr, XB, XB, ss1, 0.5f};
      pg8::gemm_phase<pg8::EpiResid<true>, pg8::StaticOrder, true, true>(lds, g, S, E); }
    xcd_barrier(xbar);
    { pg8::Gemm g{XB, WIN, M, NQKU, D}; pg8::StaticOrder S; S.init(M, NQKU, G, bx); pg8::EpiInProj E{QB, ss1, pos, kmean};
      pg8::gemm_phase<pg8::EpiInProj, pg8::StaticOrder, true, true>(lds, g, S, E); }
    { pg8::Gemm g{WIN + (size_t)NQKU * D, XB, AW, M, D}; pg8::StaticOrder S; S.init(AW, M, G, bx); pg8::EpiVT E{VTB, ss1};
      pg8::gemm_phase<pg8::EpiVT, pg8::StaticOrder, true, true>(lds, g, S, E); }
    xcd_barrier(xbar);
    {
        for (int rep = 0; rep < REP_ATT; ++rep)
        for (int pr = vcu; pr < 256; pr += G) {
            const int bh = pr >> 3, s = pr & 7;
#pragma nounroll
            for (int k2 = 0; k2 < 2; ++k2) att::attn_unit(bh >> 3, bh & 7, k2 ? s : 15 - s, QB, KB, VTB, kmean, MIX, lds);
        }
        int tidp = threadIdx.x; asm volatile("" : "+v"(tidp));
        for (int L = bx; L < 256; L += G) {
            const int g = L >> 6, pm = L & 63;
            if (g == 0) pooled_tile<2>(UB, PL, g, pm, tidp); else if (g == 1) pooled_tile<4>(UB, PL, g, pm, tidp); else if (g == 2) pooled_tile<8>(UB, PL, g, pm, tidp); else pooled_tile<16>(UB, PL, g, pm, tidp);
            asm volatile("s_waitcnt vmcnt(0)" ::: "memory");
            __syncthreads();
            int Kp = 256; asm volatile("" : "+s"(Kp));
            pg8::Gemm gm{PL, WPOOL, 4 * M, 1024, Kp}; pg8::OneUnit S; S.u0.pm = g * 64 + pm; S.u0.pn = g; pg8::EpiPool E{MIX, pool_scale};
            pg8::gemm_phase<pg8::EpiPool, pg8::OneUnit, false, true>(lds, gm, S, E);
        }
    }
    xcd_barrier(xbar);
    { pg8::Gemm g{MIX, WOUT, M, D, D}; pg8::StaticOrder S; S.init(M, D, G, bx); pg8::EpiResid<true> E{nullptr, XB, XB, ss2, 1.0f};
      pg8::gemm_phase<pg8::EpiResid<true>, pg8::StaticOrder, true, true>(lds, g, S, E); }
    xcd_barrier(xbar);
    { pg8::Gemm g{XB, WGU2, M, 2 * FF, D}; pg8::StaticOrder S; S.init(M, 2 * FF, G, bx); pg8::EpiSwiglu E{ACT, ss2};
      pg8::gemm_phase<pg8::EpiSwiglu, pg8::StaticOrder, true, true>(lds, g, S, E); }
    xcd_barrier(xbar);
    { pg8::Gemm g{ACT, WD2, M, D, FF}; pg8::StaticOrder S; S.init(M, D, G, bx); pg8::EpiResid<true> E{nullptr, XB, XB, ss3, 0.5f};
      pg8::gemm_phase<pg8::EpiResid<true>, pg8::StaticOrder, true, true>(lds, g, S, E); }
    xcd_barrier(xbar);
    int lane8 = threadIdx.x & 63; asm volatile("" : "+v"(lane8));
    for (int m = gw; m < M; m += NGW) {
        const u32x4* xr = (const u32x4*)(XB + (size_t)m * D) + lane8; f32x4* orow = (f32x4*)(out + (size_t)m * D) + 2 * lane8; const f32x4* gr = (const f32x4*)g_fin + 2 * lane8;
        const float rs = __builtin_amdgcn_rsqf(ss3[m] * (1.0f / D) + EPS);
#pragma unroll
        for (int j = 0; j < 4; ++j) { const u32x4 h = xr[64 * j]; const f32x4 g0 = gr[128 * j], g1 = gr[128 * j + 1];
            const f32x4 v0 = (f32x4){__builtin_bit_cast(float, h[0] << 16), __builtin_bit_cast(float, h[0] & 0xffff0000u), __builtin_bit_cast(float, h[1] << 16), __builtin_bit_cast(float, h[1] & 0xffff0000u)};
            const f32x4 v1 = (f32x4){__builtin_bit_cast(float, h[2] << 16), __builtin_bit_cast(float, h[2] & 0xffff0000u), __builtin_bit_cast(float, h[3] << 16), __builtin_bit_cast(float, h[3] & 0xffff0000u)};
            orow[128 * j] = v0 * rs * g0; orow[128 * j + 1] = v1 * rs * g1; }
    }
}

extern "C" void kernel_launch(void* const* d_in, const int* in_sizes, int n_in, void* d_out, int out_size, void* d_ws, size_t ws_size, hipStream_t stream) {
    static int grid = 0;
    if (grid == 0) {
        if (n_in != 16 || out_size != M * D || ws_size < WS_END) { fprintf(stderr, "kernel_launch: unexpected problem (n_in %d out %d ws %zu need %zu)\n", n_in, out_size, ws_size, (size_t)WS_END); grid = -1; return; }
        int dev = 0, cus = 0, per_cu = 0;
        (void)hipGetDevice(&dev);
        (void)hipDeviceGetAttribute(&cus, hipDeviceAttributeMultiprocessorCount, dev);
        (void)hipFuncSetAttribute((const void*)fwd_kernel, hipFuncAttributeMaxDynamicSharedMemorySize, LDS_BYTES);
        (void)hipOccupancyMaxActiveBlocksPerMultiprocessor(&per_cu, (const void*)fwd_kernel, NWAVES * 64, LDS_BYTES);
        if (per_cu < 1) { fprintf(stderr, "kernel_launch: occupancy query says %d blocks per CU\n", per_cu); per_cu = 1; }
        grid = cus;
    }
    if (grid < 0) return;
    if (hipMemsetAsync((char*)d_ws + WS_CTL, 0, CTL_BYTES, stream) != hipSuccess) { fprintf(stderr, "kernel_launch: memset of barrier words failed\n"); return; }
    Args a{};
    for (int i = 0; i < 16; ++i) a.in[i] = (const float*)d_in[i];
    a.out = (float*)d_out; a.ws = (unsigned char*)d_ws;
    void* kargs[] = {&a};
    hipError_t e = hipLaunchCooperativeKernel((const void*)fwd_kernel, dim3(grid), dim3(NWAVES * 64), kargs, LDS_BYTES, stream);
    if (e != hipSuccess) fprintf(stderr, "cooperative launch failed: %s (grid %d)\n", hipGetErrorString(e), grid);
}
```

```cpp
#include <hip/hip_runtime.h>
#include <hip/hip_cooperative_groups.h>
#include <cstdio>
#include <cstdint>
namespace cg = cooperative_groups;
#ifndef REP_P0
#define REP_P0 1
#endif
#ifndef REP_P1
#define REP_P1 1
#endif
#ifndef REP_ATT
#define REP_ATT 1
#endif

#define LAS __attribute__((address_space(3)))
typedef unsigned short bf16_t;
typedef short bf16x8 __attribute__((ext_vector_type(8)));
typedef float f32x4 __attribute__((ext_vector_type(4)));
typedef float f32x16 __attribute__((ext_vector_type(16)));
typedef unsigned u32x4 __attribute__((ext_vector_type(4)));
typedef unsigned u32x2 __attribute__((ext_vector_type(2)));

constexpr int M = 16384, SEQ = 4096, D = 2048, FF = 5632, AW = 1024, NH = 8, HD = 128;
constexpr int NQKU = 3072;
constexpr float EPS = 1e-6f;
constexpr float NEGBIG = -1e30f;
constexpr float QSCALE = 0.08838834764831845f * 1.4426950408889634f;

__device__ __forceinline__ unsigned cvt_pk_bf16(float lo, float hi) { unsigned r; asm volatile("v_cvt_pk_bf16_f32 %0, %1, %2" : "=v"(r) : "v"(lo), "v"(hi)); return r; }
__device__ __forceinline__ float bf2f(unsigned short b) { return __builtin_bit_cast(float, (unsigned)b << 16); }

namespace pg8 {
constexpr int BM = 256, BK = 64, HALF = 128, HTB = HALF * BK * 2, STAGE_BYTES = 8 * HTB, NXCD = 8, WGM = 8;
__host__ __device__ __forceinline__ int lds_byte(int r, int c) { const int st = (r >> 4) * 2 + (c >> 5), rr = r & 15, cc = c & 31, ob = rr * 64 + cc * 2; return st * 1024 + (ob ^ (((ob >> 9) & 1) << 5)); }
__host__ __device__ __forceinline__ void stage_rc(int b, int& R, int& C) { const int st = b / 1024, sb = b % 1024, swz = sb ^ (((sb >> 9) & 1) << 5); R = (st >> 1) * 16 + swz / 64; C = (st & 1) * 32 + (swz % 64) / 2; }
__host__ __device__ __forceinline__ int perm32(int rho) { const int n = rho >> 4, i = rho & 15; return 8 * (i >> 2) + 4 * n + (i & 3); }

struct Unit { int pm, pn; };
struct Gemm { const bf16_t* A; const bf16_t* Bt; int M, N, K; };

struct StaticOrder {
    int nM, nN, nwg, G, c;
    __device__ void init(int M_, int N_, int G_, int c_) { nM = M_ / BM; nN = N_ / BM; nwg = nM * nN; G = G_; c = c_; }
    __device__ bool next(int i, Unit& u) const {
        const long L = (long)i * G + c; if (L >= nwg) return false;
        int wgid = (int)L; { const int q = nwg / NXCD, r = nwg % NXCD, xcd = wgid % NXCD, off = wgid / NXCD; wgid = (xcd < r ? xcd * (q + 1) : r * (q + 1) + (xcd - r) * q) + off; }
        const int nig = WGM * nN, gid = wgid / nig, fm = gid * WGM, gsz = (nM - fm) < WGM ? (nM - fm) : WGM;
        u.pm = fm + ((wgid % nig) % gsz); u.pn = (wgid % nig) / gsz; return true;
    }
    __device__ __forceinline__ void a_ready(const Unit&) const {}
    __device__ __forceinline__ void done(const Unit&) const {}
};
struct OneUnit {
    Unit u0;
    __device__ bool next(int i, Unit& u) const { if (i > 0) return false; u = u0; return true; }
    __device__ __forceinline__ void a_ready(const Unit&) const {}
    __device__ __forceinline__ void done(const Unit&) const {}
};

template <class Epi, class Sched, bool ALIGN_EPI = false, bool SP2 = false>
__device__ __forceinline__ void gemm_phase(LAS unsigned char* lds, const Gemm g, const Sched& S, const Epi& E) {
    int tid = threadIdx.x; asm volatile("" : "+v"(tid));
    const int wid = __builtin_amdgcn_readfirstlane(tid >> 6), lane = tid & 63, wr = wid >> 2, wc = wid & 3, fr = lane & 15, fq = lane >> 4;
    const int K = g.K, nt = K / BK;
    unsigned voffA[2], voffB[2];
#pragma unroll
    for (int i = 0; i < 2; ++i) { int R, C; stage_rc(tid * 16 + i * 8192, R, C); const int Rb = Epi::PERM ? ((R & ~31) + perm32(R & 31)) : R;
        voffA[i] = (unsigned)(R * K + C) * 2u; voffB[i] = (unsigned)(Rb * K + C) * 2u; }
    const size_t kstep = (size_t)(BK * 2);
    const size_t hstep = (size_t)HALF * K * 2;
    const size_t tstep = 2 * hstep;
    const unsigned ldsw = (unsigned)wid * 1024u;
    const int aoff = lds_byte(wr * 64 + fr, fq * 8), boff = lds_byte(wc * 32 + fr, fq * 8);
#define PG8_SA(b, h) (((b) * 2 + (h)) * HTB)
#define PG8_SB(b, h) ((4 + (b) * 2 + (h)) * HTB)
#define PG8_STAGE(bufoff, gbase, voff) do { _Pragma("unroll") for (int _i = 0; _i < 2; ++_i) \
        __builtin_amdgcn_global_load_lds((const unsigned*)((const char*)(gbase) + (voff)[_i]), (LAS unsigned*)(lds + (bufoff) + ldsw + _i * 8192), 16, 0, 0); } while (0)
#define PG8_LDA(dst, b, h) do { _Pragma("unroll") for (int m = 0; m < 4; ++m) _Pragma("unroll") for (int k = 0; k < 2; ++k) dst[m][k] = *(const LAS bf16x8*)(lds + PG8_SA(b, h) + aoff + m * 2048 + k * 1024); } while (0)
#define PG8_LDB(dst, b, h) do { _Pragma("unroll") for (int n = 0; n < 2; ++n) _Pragma("unroll") for (int k = 0; k < 2; ++k) dst[n][k] = *(const LAS bf16x8*)(lds + PG8_SB(b, h) + boff + n * 2048 + k * 1024); } while (0)
#define PG8_MMA(ai, bj, At, Bt) do { __builtin_amdgcn_s_setprio(1); _Pragma("unroll") for (int m = 0; m < 4; ++m) _Pragma("unroll") for (int n = 0; n < 2; ++n) _Pragma("unroll") for (int k = 0; k < 2; ++k) \
        acc[ai][bj][m][n] = __builtin_amdgcn_mfma_f32_16x16x32_bf16(Bt[n][k], At[m][k], acc[ai][bj][m][n], 0, 0, 0); __builtin_amdgcn_s_setprio(0); } while (0)
#define PG8_WAIT_V(n) asm volatile("s_waitcnt vmcnt(" #n ")" ::: "memory")
#define PG8_WAIT_L(n) asm volatile("s_waitcnt lgkmcnt(" #n ")" ::: "memory")
#define PG8_BAR __builtin_amdgcn_s_barrier()
#define PG8_SCHED __builtin_amdgcn_sched_barrier(0)
    Unit cur, nxt; int ui = 0;
    if (!S.next(0, cur)) return;
    typename Epi::Pre pre_cur = E.pre(cur, wr, fr), pre_nxt = pre_cur;
    f32x4 acc[2][2][4][2];
#pragma unroll
    for (int a = 0; a < 2; ++a)
#pragma unroll
        for (int b = 0; b < 2; ++b)
#pragma unroll
            for (int m = 0; m < 4; ++m)
#pragma unroll
                for (int n = 0; n < 2; ++n) acc[a][b][m][n] = (f32x4){0.f, 0.f, 0.f, 0.f};
    bf16x8 At[4][2], B0[2][2], B1[2][2];
    const char* cA = (const char*)g.A + (size_t)cur.pm * tstep; const char* cB = (const char*)g.Bt + (size_t)cur.pn * tstep;
    S.a_ready(cur);
    if constexpr (SP2) {
        PG8_STAGE(PG8_SB(0, 0), cB, voffB); PG8_STAGE(PG8_SB(0, 1), cB + hstep, voffB); PG8_STAGE(PG8_SA(0, 0), cA, voffA); PG8_STAGE(PG8_SA(0, 1), cA + hstep, voffA);
        if (wr == 1) PG8_BAR;
        PG8_WAIT_V(2); PG8_BAR;
        PG8_STAGE(PG8_SB(1, 0), cB + kstep, voffB); PG8_STAGE(PG8_SA(1, 0), cA + kstep, voffA); PG8_STAGE(PG8_SB(1, 1), cB + hstep + kstep, voffB);
        PG8_WAIT_V(6); PG8_BAR;
    } else {
        PG8_STAGE(PG8_SB(0, 0), cB, voffB); PG8_STAGE(PG8_SA(0, 0), cA, voffA); PG8_STAGE(PG8_SB(0, 1), cB + hstep, voffB); PG8_STAGE(PG8_SA(0, 1), cA + hstep, voffA);
        if (wr == 1) PG8_BAR;
        PG8_WAIT_V(4); PG8_BAR;
        PG8_STAGE(PG8_SB(1, 0), cB + kstep, voffB); PG8_STAGE(PG8_SA(1, 0), cA + kstep, voffA); PG8_STAGE(PG8_SB(1, 1), cB + hstep + kstep, voffB);
        PG8_WAIT_V(6); PG8_BAR;
    }
    for (;;) {
        const bool has_next = S.next(ui + 1, nxt);
        const char* nA = has_next ? (const char*)g.A + (size_t)nxt.pm * tstep : cA; const char* nB = has_next ? (const char*)g.Bt + (size_t)nxt.pn * tstep : cB;
        for (int t = 0; t < nt; t += 2) {
            const bool last = (t == nt - 2);
            const char* a1 = cA + (size_t)(t + 1) * kstep;
            const char* a2 = last ? nA : cA + (size_t)(t + 2) * kstep; const char* b2 = last ? nB : cB + (size_t)(t + 2) * kstep;
            const char* a3 = a2 + kstep; const char* b3 = b2 + kstep;
            if (last && has_next) { S.a_ready(nxt); pre_nxt = E.pre(nxt, wr, fr); }
            if constexpr (SP2) {
            PG8_LDB(B0, 0, 0); PG8_LDB(B1, 0, 1); PG8_SCHED; PG8_LDA(At, 0, 0); PG8_STAGE(PG8_SA(1, 1), a1 + hstep, voffA);
            PG8_WAIT_V(8); PG8_WAIT_L(0); PG8_BAR; PG8_MMA(0, 0, At, B0); PG8_MMA(0, 1, At, B1); PG8_BAR; PG8_SCHED;
            PG8_LDA(At, 0, 1); PG8_STAGE(PG8_SB(0, 0), b2, voffB); PG8_STAGE(PG8_SB(0, 1), b2 + hstep, voffB); PG8_STAGE(PG8_SA(0, 0), a2, voffA);
            PG8_WAIT_V(8); PG8_WAIT_L(0); PG8_BAR; PG8_MMA(1, 0, At, B0); PG8_MMA(1, 1, At, B1); PG8_BAR; PG8_SCHED;
            PG8_LDB(B0, 1, 0); PG8_LDB(B1, 1, 1); PG8_SCHED; PG8_LDA(At, 1, 0); PG8_STAGE(PG8_SA(0, 1), a2 + hstep, voffA);
            PG8_WAIT_V(8); PG8_WAIT_L(0); PG8_BAR; PG8_MMA(0, 0, At, B0); PG8_MMA(0, 1, At, B1); PG8_BAR; PG8_SCHED;
            PG8_LDA(At, 1, 1); PG8_STAGE(PG8_SB(1, 0), b3, voffB); PG8_STAGE(PG8_SB(1, 1), b3 + hstep, voffB); PG8_STAGE(PG8_SA(1, 0), a3, voffA);
            PG8_WAIT_V(8); PG8_WAIT_L(0); PG8_BAR; PG8_MMA(1, 0, At, B0); PG8_MMA(1, 1, At, B1); PG8_BAR; PG8_SCHED;
            } else {
            PG8_LDB(B0, 0, 0); PG8_SCHED; PG8_LDA(At, 0, 0); PG8_STAGE(PG8_SA(1, 1), a1 + hstep, voffA);
            PG8_WAIT_L(8); PG8_BAR; PG8_WAIT_L(0); PG8_MMA(0, 0, At, B0); PG8_BAR; PG8_SCHED;
            PG8_LDB(B1, 0, 1); PG8_STAGE(PG8_SB(0, 0), b2, voffB);
            PG8_BAR; PG8_WAIT_L(0); PG8_MMA(0, 1, At, B1); PG8_BAR;
            PG8_LDA(At, 0, 1); PG8_STAGE(PG8_SA(0, 0), a2, voffA);
            PG8_BAR; PG8_WAIT_L(0); PG8_MMA(1, 0, At, B0); PG8_BAR; PG8_SCHED;
            PG8_STAGE(PG8_SB(0, 1), b2 + hstep, voffB);
            PG8_WAIT_V(6); PG8_BAR; PG8_MMA(1, 1, At, B1); PG8_BAR;
            PG8_LDB(B0, 1, 0); PG8_SCHED; PG8_LDA(At, 1, 0); PG8_STAGE(PG8_SA(0, 1), a2 + hstep, voffA);
            PG8_WAIT_L(8); PG8_BAR; PG8_WAIT_L(0); PG8_MMA(0, 0, At, B0); PG8_BAR; PG8_SCHED;
            PG8_LDB(B1, 1, 1); PG8_STAGE(PG8_SB(1, 0), b3, voffB);
            PG8_BAR; PG8_WAIT_L(0); PG8_MMA(0, 1, At, B1); PG8_BAR;
            PG8_LDA(At, 1, 1); PG8_STAGE(PG8_SA(1, 0), a3, voffA);
            PG8_BAR; PG8_WAIT_L(0); PG8_MMA(1, 0, At, B0); PG8_BAR; PG8_SCHED;
            PG8_STAGE(PG8_SB(1, 1), b3 + hstep, voffB);
            PG8_WAIT_V(6); PG8_BAR; PG8_MMA(1, 1, At, B1); PG8_BAR;
            }
        }
        if constexpr (ALIGN_EPI) { if (wr == 0) PG8_BAR; }
        E(acc, cur, wr, wc, fr, fq, pre_cur); S.done(cur);
        if (!has_next) break;
        pre_cur = pre_nxt;
#pragma unroll
        for (int a = 0; a < 2; ++a)
#pragma unroll
            for (int b = 0; b < 2; ++b)
#pragma unroll
                for (int m = 0; m < 4; ++m)
#pragma unroll
                    for (int n = 0; n < 2; ++n) acc[a][b][m][n] = (f32x4){0.f, 0.f, 0.f, 0.f};
        cur = nxt; cA = nA; cB = nB; ++ui;
        if constexpr (ALIGN_EPI) { if (wr == 1) PG8_BAR; }
    }
    PG8_WAIT_V(0);
    if constexpr (!ALIGN_EPI) { if (wr == 0) PG8_BAR; }
    PG8_BAR;
#undef PG8_SA
#undef PG8_SB
#undef PG8_STAGE
#undef PG8_LDA
#undef PG8_LDB
#undef PG8_MMA
#undef PG8_WAIT_V
#undef PG8_WAIT_L
#undef PG8_BAR
#undef PG8_SCHED
}

__device__ __forceinline__ float silu_mul(float g, float u) { return g * u * __builtin_amdgcn_rcpf(1.0f + __builtin_amdgcn_exp2f(-1.4426950408889634f * g)); }

struct PreNone {};
struct PreRows { float v[8]; };
__device__ __forceinline__ PreRows load_rows8(const float* ss, const Unit& u, int wr, int fr) {
    PreRows p; const float* b = ss + u.pm * BM + wr * 64 + fr;
#pragma unroll
    for (int ai = 0; ai < 2; ++ai)
#pragma unroll
        for (int m = 0; m < 4; ++m) p.v[ai * 4 + m] = b[ai * HALF + m * 16];
    return p;
}
struct EpiSwiglu {
    static constexpr bool PERM = true;
    typedef PreRows Pre;
    bf16_t* O; const float* ss;
    __device__ __forceinline__ Pre pre(const Unit& u, int wr, int fr) const { return load_rows8(ss, u, wr, fr); }
    __device__ __forceinline__ void operator()(const f32x4 (&acc)[2][2][4][2], const Unit& u, int wr, int wc, int fr, int fq, const Pre& pr) const {
        const int row0 = u.pm * BM + wr * 64 + fr, col0 = u.pn * HALF + wc * 32 + 8 * fq;
#pragma unroll
        for (int ai = 0; ai < 2; ++ai)
#pragma unroll
            for (int m = 0; m < 4; ++m) {
                const int row = row0 + ai * HALF + m * 16;
                const float rs = __builtin_amdgcn_rsqf(pr.v[ai * 4 + m] * (1.0f / D) + EPS);
                const f32x4 g0 = acc[ai][0][m][0] * rs, g1 = acc[ai][0][m][1] * rs, u0 = acc[ai][1][m][0] * rs, u1 = acc[ai][1][m][1] * rs;
                u32x4 w;
                w.x = cvt_pk_bf16(silu_mul(g0[0], u0[0]), silu_mul(g0[1], u0[1])); w.y = cvt_pk_bf16(silu_mul(g0[2], u0[2]), silu_mul(g0[3], u0[3]));
                w.z = cvt_pk_bf16(silu_mul(g1[0], u1[0]), silu_mul(g1[1], u1[1])); w.w = cvt_pk_bf16(silu_mul(g1[2], u1[2]), silu_mul(g1[3], u1[3]));
                *(u32x4*)(O + (size_t)row * FF + col0) = w;
            }
    }
};

template <bool BASE_BF16> struct EpiResid {
    static constexpr bool PERM = true;
    typedef PreNone Pre;
    const float* basef; const bf16_t* baseb; bf16_t* xb; float* ss; float alpha;
    __device__ __forceinline__ Pre pre(const Unit&, int, int) const { return Pre{}; }
    struct Row { f32x4 f[2][2]; u32x4 h[2]; };
    __device__ __forceinline__ void load(Row& r, size_t off) const {
#pragma unroll
        for (int bj = 0; bj < 2; ++bj) {
            if (BASE_BF16) r.h[bj] = *(const u32x4*)(baseb + off + bj * HALF);
            else { r.f[bj][0] = *(const f32x4*)(basef + off + bj * HALF); r.f[bj][1] = *(const f32x4*)(basef + off + bj * HALF + 4); } }
    }
    __device__ __forceinline__ void row(const Row& r, const f32x4 (&a)[2][2][4][2], int ai, int m, int row_, int col0, int fq) const {
        const size_t off = (size_t)row_ * D + col0; float sq = 0.f;
#pragma unroll
        for (int bj = 0; bj < 2; ++bj) {
            f32x4 b0, b1;
            if (BASE_BF16) { const u32x4 h = r.h[bj];
                b0 = (f32x4){__builtin_bit_cast(float, h[0] << 16), __builtin_bit_cast(float, h[0] & 0xffff0000u), __builtin_bit_cast(float, h[1] << 16), __builtin_bit_cast(float, h[1] & 0xffff0000u)};
                b1 = (f32x4){__builtin_bit_cast(float, h[2] << 16), __builtin_bit_cast(float, h[2] & 0xffff0000u), __builtin_bit_cast(float, h[3] << 16), __builtin_bit_cast(float, h[3] & 0xffff0000u)}; }
            else { b0 = r.f[bj][0]; b1 = r.f[bj][1]; }
            const f32x4 v0 = b0 + a[ai][bj][m][0] * alpha, v1 = b1 + a[ai][bj][m][1] * alpha;
            u32x4 w; w.x = cvt_pk_bf16(v0[0], v0[1]); w.y = cvt_pk_bf16(v0[2], v0[3]); w.z = cvt_pk_bf16(v1[0], v1[1]); w.w = cvt_pk_bf16(v1[2], v1[3]);
            *(u32x4*)(xb + off + bj * HALF) = w;
            sq += (v0[0] * v0[0] + v0[1] * v0[1]) + (v0[2] * v0[2] + v0[3] * v0[3]) + (v1[0] * v1[0] + v1[1] * v1[1]) + (v1[2] * v1[2] + v1[3] * v1[3]);
        }
        sq += __shfl_xor(sq, 16); sq += __shfl_xor(sq, 32);
        if (fq == 0) unsafeAtomicAdd(ss + row_, sq);
    }
    __device__ __forceinline__ void operator()(const f32x4 (&acc)[2][2][4][2], const Unit& u, int wr, int wc, int fr, int fq, const Pre&) const {
        const int row0 = u.pm * BM + wr * 64 + fr, col0 = u.pn * BM + wc * 32 + 8 * fq;
        Row pre[4];
#pragma unroll
        for (int m = 0; m < 4; ++m) load(pre[m], (size_t)(row0 + m * 16) * D + col0);
        asm volatile("" ::: "memory");
#pragma unroll
        for (int m = 0; m < 4; ++m) {
            row(pre[m], acc, 0, m, row0 + m * 16, col0, fq);
            load(pre[m], (size_t)(row0 + HALF + m * 16) * D + col0);
            asm volatile("" ::: "memory");
        }
#pragma unroll
        for (int m = 0; m < 4; ++m) { row(pre[m], acc, 1, m, row0 + HALF + m * 16, col0, fq); asm volatile("" ::: "memory"); }
    }
};

__device__ const float INVF[16] = {1.000000000e+00f, 4.403665960e-01f, 1.939227432e-01f, 8.539710194e-02f, 3.760603070e-02f, 1.656044088e-02f, 7.292664610e-03f, 3.211446106e-03f,
                                   1.414213562e-03f, 6.227724371e-04f, 2.742481884e-04f, 1.207697351e-04f, 5.318295734e-05f, 2.341999971e-05f, 1.031338525e-05f, 4.541670478e-06f};

struct EpiInProj {
    static constexpr bool PERM = false;
    typedef PreRows Pre;
    bf16_t* QKU; const float* ss; const int* pos; float* kmean;
    __device__ __forceinline__ Pre pre(const Unit& u, int wr, int fr) const { return load_rows8(ss, u, wr, fr); }
    __device__ __forceinline__ void operator()(f32x4 (&acc)[2][2][4][2], const Unit& u, int wr, int wc, int fr, int fq, const Pre& pr) const {
        const int row0 = u.pm * BM + wr * 64 + fr;
        const int kind = u.pn >> 2;
        const int ct = (u.pn & 3) * BM + wc * 32 + 4 * fq;
        bf16_t* dst = QKU + (size_t)kind * ((size_t)M * AW);
        float invf[4];
#pragma unroll
        for (int j = 0; j < 4; ++j) invf[j] = INVF[4 * fq + j];
#pragma unroll
        for (int ai = 0; ai < 2; ++ai)
#pragma unroll
            for (int m = 0; m < 4; ++m) {
                const int row = row0 + ai * HALF + m * 16;
                const float rs = __builtin_amdgcn_rsqf(pr.v[ai * 4 + m] * (1.0f / D) + EPS);
#pragma unroll
                for (int bj = 0; bj < 2; ++bj)
#pragma unroll
                    for (int n = 0; n < 2; ++n) acc[ai][bj][m][n] = acc[ai][bj][m][n] * rs;
                if (kind < 2 && wc == 0) {
                    const float p = (float)pos[row];
#pragma unroll
                    for (int j = 0; j < 4; ++j) {
                        const float ang = p * invf[j];
                        double rev = (double)ang * 0.15915494309189535; rev -= __builtin_floor(rev);
                        const float fr_ = (float)rev;
                        const float sn = __builtin_amdgcn_sinf(fr_), cs = __builtin_amdgcn_cosf(fr_);
#pragma unroll
                        for (int bj = 0; bj < 2; ++bj) { const float x1 = acc[ai][bj][m][0][j], x2 = acc[ai][bj][m][1][j];
                            acc[ai][bj][m][0][j] = x1 * cs - x2 * sn; acc[ai][bj][m][1][j] = x2 * cs + x1 * sn; }
                    }
                }
                const float qs = (kind == 0) ? QSCALE : 1.0f;
#pragma unroll
                for (int bj = 0; bj < 2; ++bj)
#pragma unroll
                    for (int n = 0; n < 2; ++n) { const f32x4 v = acc[ai][bj][m][n] * qs; u32x2 w; w.x = cvt_pk_bf16(v[0], v[1]); w.y = cvt_pk_bf16(v[2], v[3]);
                        *(u32x2*)(dst + (size_t)row * AW + ct + bj * HALF + n * 16) = w; }
            }
        if (kind == 1) {
            const int b = u.pm >> 4, blk = u.pm & 15;
#pragma unroll
            for (int bj = 0; bj < 2; ++bj)
#pragma unroll
                for (int n = 0; n < 2; ++n) {
                    f32x4 s = (f32x4){0.f, 0.f, 0.f, 0.f};
#pragma unroll
                    for (int ai = 0; ai < 2; ++ai)
#pragma unroll
                        for (int m = 0; m < 4; ++m) s += acc[ai][bj][m][n];
#pragma unroll
                    for (int j = 0; j < 4; ++j) { float v = s[j]; v += __shfl_xor(v, 1); v += __shfl_xor(v, 2); v += __shfl_xor(v, 4); v += __shfl_xor(v, 8); s[j] = v; }
                    if (fr == 0) { const int h = (u.pn & 3) * 2 + bj; float* km = kmean + ((size_t)((b * NH + h) * 16 + blk)) * HD + wc * 32 + n * 16 + 4 * fq;
#pragma unroll
                        for (int j = 0; j < 4; ++j) unsafeAtomicAdd(km + j, s[j] * (1.0f / 256.0f)); }
                }
        }
    }
};

struct EpiVT {
    static constexpr bool PERM = true;
    typedef PreNone Pre;
    bf16_t* VT; const float* ss;
    __device__ __forceinline__ Pre pre(const Unit&, int, int) const { return Pre{}; }
    __device__ __forceinline__ void operator()(const f32x4 (&acc)[2][2][4][2], const Unit& u, int wr, int wc, int fr, int fq, const Pre&) const {
        const int row0 = u.pm * BM + wr * 64 + fr, col0 = u.pn * BM + wc * 32 + 8 * fq;
        f32x4 rs[2][2];
#pragma unroll
        for (int bj = 0; bj < 2; ++bj)
#pragma unroll
            for (int n = 0; n < 2; ++n) { const f32x4 s = *(const f32x4*)(ss + col0 + bj * HALF + 4 * n);
#pragma unroll
                for (int j = 0; j < 4; ++j) rs[bj][n][j] = __builtin_amdgcn_rsqf(s[j] * (1.0f / D) + EPS); }
#pragma unroll
        for (int ai = 0; ai < 2; ++ai)
#pragma unroll
            for (int m = 0; m < 4; ++m) {
                const int row = row0 + ai * HALF + m * 16;
#pragma unroll
                for (int bj = 0; bj < 2; ++bj) { const f32x4 v0 = acc[ai][bj][m][0] * rs[bj][0], v1 = acc[ai][bj][m][1] * rs[bj][1];
                    u32x4 w; w.x = cvt_pk_bf16(v0[0], v0[1]); w.y = cvt_pk_bf16(v0[2], v0[3]); w.z = cvt_pk_bf16(v1[0], v1[1]); w.w = cvt_pk_bf16(v1[2], v1[3]);
                    *(u32x4*)(VT + (size_t)row * M + col0 + bj * HALF) = w; }
            }
    }
};

struct EpiPool {
    static constexpr bool PERM = true;
    typedef PreNone Pre;
    bf16_t* MIX; const float* pscale;
    __device__ __forceinline__ Pre pre(const Unit&, int, int) const { return Pre{}; }
    __device__ __forceinline__ void operator()(const f32x4 (&acc)[2][2][4][2], const Unit& u, int wr, int wc, int fr, int fq, const Pre&) const {
        const int g = u.pn; const int row0 = (u.pm - 64 * g) * BM + wr * 64 + fr, col0 = g * BM + wc * 32 + 8 * fq;
        f32x4 sc[2][2];
#pragma unroll
        for (int bj = 0; bj < 2; ++bj)
#pragma unroll
            for (int n = 0; n < 2; ++n) sc[bj][n] = *(const f32x4*)(pscale + col0 + bj * HALF + 4 * n);
#pragma unroll
        for (int ai = 0; ai < 2; ++ai)
#pragma unroll
            for (int m = 0; m < 4; ++m) {
                const int row = row0 + ai * HALF + m * 16;
#pragma unroll
                for (int bj = 0; bj < 2; ++bj) { const f32x4 v0 = acc[ai][bj][m][0] * sc[bj][0], v1 = acc[ai][bj][m][1] * sc[bj][1];
                    u32x4 w; w.x = cvt_pk_bf16(v0[0], v0[1]); w.y = cvt_pk_bf16(v0[2], v0[3]); w.z = cvt_pk_bf16(v1[0], v1[1]); w.w = cvt_pk_bf16(v1[2], v1[3]);
                    *(u32x4*)(MIX + (size_t)row * D + AW + col0 + bj * HALF) = w; }
            }
    }
};
}

namespace att {
constexpr int KROW = 272, VROW = 272, KT = 128 * KROW, VT_B = 128 * VROW;
constexpr int OFF_K = 0, OFF_V = 2 * KT, OFF_WS = 2 * KT + 2 * VT_B, LDS_NEED = OFF_WS + 8 * 256;

__device__ __forceinline__ int crow(int r, int hi) { return (r & 3) + 8 * (r >> 2) + 4 * hi; }

__device__ __forceinline__ void attn_unit(int b, int h, int qb, const bf16_t* __restrict__ Q, const bf16_t* __restrict__ K, const bf16_t* __restrict__ VT, const float* __restrict__ kmean,
                                          bf16_t* __restrict__ O, LAS unsigned char* lds) {
    int tid = threadIdx.x; asm volatile("" : "+v"(tid));
    const int lane = tid & 63, r32 = lane & 31, hi = lane >> 5; const int wid = __builtin_amdgcn_readfirstlane(tid >> 6);
    const size_t rowbase = (size_t)b * SEQ; const int q0 = qb * 256;
    const bf16_t* Qw = Q + (rowbase + q0 + wid * 32 + r32) * AW + h * HD + hi * 8;
    bf16x8 qf[8];
#pragma unroll
    for (int d0 = 0; d0 < 8; ++d0) qf[d0] = *(const bf16x8*)(Qw + d0 * 16);
    const bf16_t* gK = K + (rowbase + (tid >> 4)) * AW + h * HD + (tid & 15) * 8;
    const bf16_t* gV = VT + (size_t)(h * HD + (tid >> 4)) * M + rowbase + (tid & 15) * 8;
    const int lK = OFF_K + (tid >> 4) * KROW + (tid & 15) * 16, lV = OFF_V + (tid >> 4) * VROW + (tid & 15) * 16;
    const int pi32 = (r32 & 0x13) | ((r32 & 4) << 1) | ((r32 & 8) >> 1);
    const int kread = OFF_K + pi32 * KROW + hi * 16, vread = OFF_V + r32 * VROW + hi * 16;
    LAS float* wsf = (LAS float*)(lds + OFF_WS + wid * 256);
    const int NS = 2 * (qb + 1);
    LAS float* kml = (LAS float*)(lds + OFF_K + KT);
    f32x4 kmv = (f32x4){0.f, 0.f, 0.f, 0.f};
    if (tid < qb * 32) kmv = *(const f32x4*)(kmean + (size_t)((b * NH + h) * 16) * HD + tid * 4);
    u32x4 kr[4], vr[4];
#pragma unroll
    for (int i = 0; i < 4; ++i) { kr[i] = *(const u32x4*)(gK + (size_t)i * 32 * AW); vr[i] = *(const u32x4*)(gV + (size_t)i * 32 * M); }
    if (tid < qb * 32) *(LAS f32x4*)(kml + tid * 4) = kmv;
    __syncthreads();
    unsigned mask = 1u << qb;
    {
        float v1 = -3.0e38f, v2 = -3.0e38f, v3 = -3.0e38f; int i1 = -1, i2 = -1, i3 = -1;
        const LAS float* km = kml + hi * 8;
        for (int j = 0; j < qb; ++j) {
            float g = 0.f;
#pragma unroll
            for (int d0 = 0; d0 < 8; ++d0) { const f32x4 a = *(const LAS f32x4*)(km + j * HD + d0 * 16), c = *(const LAS f32x4*)(km + j * HD + d0 * 16 + 4);
                g += bf2f((unsigned short)qf[d0][0]) * a[0] + bf2f((unsigned short)qf[d0][1]) * a[1] + bf2f((unsigned short)qf[d0][2]) * a[2] + bf2f((unsigned short)qf[d0][3]) * a[3]
                   + bf2f((unsigned short)qf[d0][4]) * c[0] + bf2f((unsigned short)qf[d0][5]) * c[1] + bf2f((unsigned short)qf[d0][6]) * c[2] + bf2f((unsigned short)qf[d0][7]) * c[3]; }
            g += __shfl_xor(g, 32);
            if (g > v1) { v3 = v2; i3 = i2; v2 = v1; i2 = i1; v1 = g; i1 = j; }
            else if (g > v2) { v3 = v2; i3 = i2; v2 = g; i2 = j; }
            else if (g > v3) { v3 = g; i3 = j; }
        }
        if (i1 >= 0) mask |= 1u << i1; if (i2 >= 0) mask |= 1u << i2; if (i3 >= 0) mask |= 1u << i3;
    }
    unsigned wmask = 0;
    for (int j = 0; j <= qb; ++j) if (__any((int)((mask >> j) & 1u))) wmask |= 1u << j;
    wmask = __builtin_amdgcn_readfirstlane(wmask);
#pragma unroll
    for (int i = 0; i < 4; ++i) { *(LAS u32x4*)(lds + lK + i * 32 * KROW) = kr[i]; *(LAS u32x4*)(lds + lV + i * 32 * VROW) = vr[i]; }
    __syncthreads();
    float mrun = NEGBIG, lrun = 0.f;
    f32x16 o[4];
#pragma unroll
    for (int d = 0; d < 4; ++d)
#pragma unroll
        for (int r = 0; r < 16; ++r) o[d][r] = 0.f;
    const int qrel = wid * 32 + r32;
    for (int S = 0; S < NS; ++S) {
        const int cur = S & 1, j = S >> 1;
        if (S + 1 < NS) {
#pragma unroll
            for (int i = 0; i < 4; ++i) { kr[i] = *(const u32x4*)(gK + ((size_t)(S + 1) * 128 + i * 32) * AW); vr[i] = *(const u32x4*)(gV + (size_t)i * 32 * M + (S + 1) * 128); }
        }
        if ((wmask >> j) & 1u) {
#pragma unroll 1
          for (int u = 0; u < 2; ++u) {
            const int t = 2 * (S & 1) + u;
            if (j == qb && 64 * t > 32 * wid + 31) break;
            f32x16 p0, p1;
#pragma unroll
            for (int r = 0; r < 16; ++r) { p0[r] = 0.f; p1[r] = 0.f; }
            const LAS unsigned char* kb = lds + kread + cur * KT + u * 64 * KROW;
            const LAS unsigned char* vb = lds + vread + cur * VT_B + u * 128;
            bf16x8 ka[2][4];
#define ATT_LDK(B, G) do { ka[B][0] = *(const LAS bf16x8*)(kb + (2 * (G)) * 32); ka[B][1] = *(const LAS bf16x8*)(kb + 32 * KROW + (2 * (G)) * 32); \
                           ka[B][2] = *(const LAS bf16x8*)(kb + (2 * (G) + 1) * 32); ka[B][3] = *(const LAS bf16x8*)(kb + 32 * KROW + (2 * (G) + 1) * 32); } while (0)
            ATT_LDK(0, 0);
#pragma unroll
            for (int g = 0; g < 4; ++g) {
                if (g < 3) ATT_LDK((g + 1) & 1, g + 1);
                __builtin_amdgcn_sched_barrier(0);
                p0 = __builtin_amdgcn_mfma_f32_32x32x16_bf16(ka[g & 1][0], qf[2 * g], p0, 0, 0, 0);
                p1 = __builtin_amdgcn_mfma_f32_32x32x16_bf16(ka[g & 1][1], qf[2 * g], p1, 0, 0, 0);
                p0 = __builtin_amdgcn_mfma_f32_32x32x16_bf16(ka[g & 1][2], qf[2 * g + 1], p0, 0, 0, 0);
                p1 = __builtin_amdgcn_mfma_f32_32x32x16_bf16(ka[g & 1][3], qf[2 * g + 1], p1, 0, 0, 0);
                __builtin_amdgcn_sched_barrier(0);
            }
#undef ATT_LDK
            bf16x8 va[2][4];
#define ATT_LDV(B, C) do { _Pragma("unroll") for (int d = 0; d < 4; ++d) va[B][d] = *(const LAS bf16x8*)(vb + d * 32 * VROW + (C) * 32); } while (0)
            ATT_LDV(0, 0);
            __builtin_amdgcn_sched_barrier(0);
            const bool rowsel = (mask >> j) & 1u;
            if (j == qb) {
                const int kvb = 64 * t + 8 * hi;
#pragma unroll
                for (int r = 0; r < 16; ++r) { const int kv = kvb + 16 * (r >> 3) + (r & 7); if (kv > qrel) p0[r] = NEGBIG; if (kv + 32 > qrel) p1[r] = NEGBIG; }
            }
            float rm = fmaxf(p0[0], p1[0]);
#pragma unroll
            for (int r = 1; r < 16; ++r) rm = fmaxf(rm, fmaxf(p0[r], p1[r]));
            { const auto rr = __builtin_amdgcn_permlane32_swap(__float_as_uint(rm), __float_as_uint(rm), false, false); rm = fmaxf(__uint_as_float(rr[0]), __uint_as_float(rr[1])); }
            rm = rowsel ? rm : NEGBIG;
            const bool grow = rm > mrun + 8.0f;
            const float mnew = grow ? rm : mrun;
            const float alpha = grow ? __builtin_amdgcn_exp2f(mrun - mnew) : 1.0f;
            mrun = mnew;
            const float msub = rowsel ? mnew : 1e30f;
            float sum = 0.f;
#pragma unroll
            for (int r = 0; r < 16; ++r) { p0[r] = __builtin_amdgcn_exp2f(p0[r] - msub); p1[r] = __builtin_amdgcn_exp2f(p1[r] - msub); sum += p0[r] + p1[r]; }
            lrun = lrun * alpha + sum;
            if (__any(grow)) {
                if (hi == 0) wsf[r32] = alpha;
                asm volatile("s_waitcnt lgkmcnt(0)" ::: "memory");
#pragma unroll
                for (int gq = 0; gq < 4; ++gq) { const f32x4 a = *(const LAS f32x4*)(wsf + 8 * gq + 4 * hi);
#pragma unroll
                    for (int d = 0; d < 4; ++d) { o[d][4 * gq + 0] *= a[0]; o[d][4 * gq + 1] *= a[1]; o[d][4 * gq + 2] *= a[2]; o[d][4 * gq + 3] *= a[3]; } }
                asm volatile("s_waitcnt lgkmcnt(0)" ::: "memory");
            }
            bf16x8 pw[4];
            { u32x4 w;
              w.x = cvt_pk_bf16(p0[0], p0[1]); w.y = cvt_pk_bf16(p0[2], p0[3]); w.z = cvt_pk_bf16(p0[4], p0[5]); w.w = cvt_pk_bf16(p0[6], p0[7]); pw[0] = __builtin_bit_cast(bf16x8, w);
              w.x = cvt_pk_bf16(p0[8], p0[9]); w.y = cvt_pk_bf16(p0[10], p0[11]); w.z = cvt_pk_bf16(p0[12], p0[13]); w.w = cvt_pk_bf16(p0[14], p0[15]); pw[1] = __builtin_bit_cast(bf16x8, w);
              w.x = cvt_pk_bf16(p1[0], p1[1]); w.y = cvt_pk_bf16(p1[2], p1[3]); w.z = cvt_pk_bf16(p1[4], p1[5]); w.w = cvt_pk_bf16(p1[6], p1[7]); pw[2] = __builtin_bit_cast(bf16x8, w);
              w.x = cvt_pk_bf16(p1[8], p1[9]); w.y = cvt_pk_bf16(p1[10], p1[11]); w.z = cvt_pk_bf16(p1[12], p1[13]); w.w = cvt_pk_bf16(p1[14], p1[15]); pw[3] = __builtin_bit_cast(bf16x8, w); }
            __builtin_amdgcn_sched_barrier(0);
#pragma unroll
            for (int c = 0; c < 4; ++c) {
                if (c < 3) ATT_LDV((c + 1) & 1, c + 1);
                __builtin_amdgcn_sched_barrier(0);
#pragma unroll
                for (int d = 0; d < 4; ++d) o[d] = __builtin_amdgcn_mfma_f32_32x32x16_bf16(pw[c], va[c & 1][d], o[d], 0, 0, 0);
                __builtin_amdgcn_sched_barrier(0);
            }
#undef ATT_LDV
          }
        }
        if (S + 1 < NS) {
            const int nb = cur ^ 1;
#pragma unroll
            for (int i = 0; i < 4; ++i) { *(LAS u32x4*)(lds + lK + nb * KT + i * 32 * KROW) = kr[i]; *(LAS u32x4*)(lds + lV + nb * VT_B + i * 32 * VROW) = vr[i]; }
        }
        __syncthreads();
    }
    lrun += __shfl_xor(lrun, 32);
    const float inv = 1.0f / lrun;
    if (hi == 0) wsf[r32] = inv;
    asm volatile("s_waitcnt lgkmcnt(0)" ::: "memory");
    bf16_t* Ow = O + (rowbase + q0 + wid * 32) * D + h * HD + r32;
#pragma unroll
    for (int gq = 0; gq < 4; ++gq) { const f32x4 a = *(const LAS f32x4*)(wsf + 8 * gq + 4 * hi);
#pragma unroll
        for (int jj = 0; jj < 4; ++jj) { const int r = 4 * gq + jj; const int orow = crow(r, hi);
#pragma unroll
            for (int d = 0; d < 4; ++d) { const unsigned w = cvt_pk_bf16(o[d][r] * a[jj], 0.f); Ow[(size_t)orow * D + d * 32] = (bf16_t)(w & 0xffffu); } } }
    asm volatile("s_waitcnt lgkmcnt(0)" ::: "memory");
    __syncthreads();
}
}


#define XB_TMO      128
#define XB_XCNT(j)  (256  + 64 * (j))
#define XB_XSUB(j)  (1280 + 64 * (j))
#define XB_XGEN(j)  (2304 + 64 * (j))
#define XB_TOP      3328
#define XB_TOPGEN   3392
#define XCD_BAR_WORDS 3456
#define XB_SPIN_CAP (1u << 18)
__device__ __forceinline__ unsigned xb_ld(unsigned* p)              { return __hip_atomic_load(p, __ATOMIC_RELAXED, __HIP_MEMORY_SCOPE_AGENT); }
__device__ __forceinline__ unsigned xb_add(unsigned* p, unsigned v) { return __hip_atomic_fetch_add(p, v, __ATOMIC_RELAXED, __HIP_MEMORY_SCOPE_AGENT); }
__device__ __forceinline__ unsigned xb_xcc_id() { return (unsigned)__builtin_amdgcn_s_getreg((3 << 11) | 20) & 0xFu; }
#define XB_SPIN(cond, bar) do { unsigned _sp = 0; while (cond) { __builtin_amdgcn_s_sleep(1); \
    if ((++_sp & 255u) == 0u) { if (xb_ld(&(bar)[XB_TMO])) break; if (_sp > XB_SPIN_CAP) { atomicAdd(&(bar)[XB_TMO], 1u); break; } } } } while (0)
struct XcdBarrier { unsigned* bar; unsigned x; volatile LAS unsigned* st; };
__device__ __forceinline__ XcdBarrier xcd_barrier_post(unsigned* bar, volatile LAS unsigned* st) {
    XcdBarrier b; b.bar = bar; b.x = xb_xcc_id(); b.st = st;
    if (threadIdx.x == 0) (void)xb_add(&bar[XB_XCNT(b.x)], 1u);
    return b;
}
__device__ __forceinline__ void xcd_barrier_complete(unsigned* bar, unsigned x, unsigned& nloc, unsigned& nx) {
    const unsigned G = gridDim.x * gridDim.y * gridDim.z;
    unsigned sum, cnt, mine, sp = 0u;
    for (;;) {
        sum = 0u; cnt = 0u; mine = 0u;
#pragma unroll
        for (unsigned j = 0; j < 16; ++j) { const unsigned c = xb_ld(&bar[XB_XCNT(j)]); sum += c; cnt += (c > 0u) ? 1u : 0u; mine = (j == x) ? c : mine; }
        if (sum == G) break;
        __builtin_amdgcn_s_sleep(1);
        if ((++sp & 255u) == 0u) { if (xb_ld(&bar[XB_TMO])) break; if (sp > XB_SPIN_CAP) { atomicAdd(&bar[XB_TMO], 1u); break; } }
    }
    nloc = mine > 0u ? mine : 1u; nx = cnt > 0u ? cnt : 1u;
}
__device__ __forceinline__ void xcd_barrier(const XcdBarrier& b) {
    asm volatile("s_waitcnt vmcnt(0)" ::: "memory");
    __syncthreads();
    if (threadIdx.x == 0) {
        unsigned* bar = b.bar;
        __builtin_amdgcn_s_waitcnt(0);
        unsigned nloc = b.st[0], nx = b.st[1];
        if (nloc == 0u) { xcd_barrier_complete(bar, b.x, nloc, nx); b.st[0] = nloc; b.st[1] = nx; }
        const unsigned old = xb_add(&bar[XB_XSUB(b.x)], 1u);
        const unsigned gen = old / nloc;
        if (old + 1u == (gen + 1u) * nloc) {
            __builtin_amdgcn_fence(__ATOMIC_RELEASE, "agent");
            asm volatile("s_waitcnt vmcnt(0)" ::: "memory");
            const unsigned og = xb_add(&bar[XB_TOP], 1u);
            const unsigned tg = og / nx;
            if (og + 1u == (tg + 1u) * nx) xb_add(&bar[XB_TOPGEN], 1u);
            else XB_SPIN(xb_ld(&bar[XB_TOPGEN]) == tg, bar);
            __builtin_amdgcn_fence(__ATOMIC_ACQUIRE, "agent");
            xb_add(&bar[XB_XGEN(b.x)], 1u);
            asm volatile("s_waitcnt vmcnt(0)" ::: "memory");
        } else {
            XB_SPIN(xb_ld(&bar[XB_XGEN(b.x)]) == gen, bar);
            __builtin_amdgcn_fence(__ATOMIC_ACQUIRE, "agent");
            asm volatile("s_waitcnt vmcnt(0)" ::: "memory");
        }
    }
    __syncthreads();
}

constexpr int NWAVES = 8;
constexpr int LDS_BYTES = 147456, LDS_MISC = 147200;
constexpr size_t al256(size_t x) { return (x + 255) & ~(size_t)255; }
constexpr size_t WS_CTL = 0, CTL_BYTES = 16384;
constexpr size_t WS_SS = CTL_BYTES;
constexpr size_t WS_KMEAN = WS_SS + (size_t)4 * M * 4;
constexpr size_t WS_WGU1 = WS_KMEAN + (size_t)4 * NH * 16 * HD * 4;
constexpr size_t WS_WD1 = WS_WGU1 + (size_t)2 * FF * D * 2;
constexpr size_t WS_WIN = WS_WD1 + (size_t)D * FF * 2;
constexpr size_t WS_WPOOL = WS_WIN + (size_t)4096 * D * 2;
constexpr size_t WS_WOUT = WS_WPOOL + (size_t)1024 * 256 * 2;
constexpr size_t WS_WGU2 = WS_WOUT + (size_t)D * D * 2;
constexpr size_t WS_WD2 = WS_WGU2 + (size_t)2 * FF * D * 2;
constexpr size_t WS_XB = WS_WD2 + (size_t)D * FF * 2;
constexpr size_t WS_ACT = WS_XB + (size_t)M * D * 2;
constexpr size_t WS_Q = WS_ACT, WS_K = WS_Q + (size_t)M * AW * 2, WS_U = WS_K + (size_t)M * AW * 2, WS_VT = WS_U + (size_t)M * AW * 2, WS_PL = WS_VT + (size_t)M * AW * 2;
constexpr size_t WS_MIX = WS_ACT + (size_t)M * FF * 2;
constexpr size_t WS_END = WS_MIX + (size_t)M * D * 2;
static_assert(WS_PL + (size_t)M * AW * 2 <= WS_MIX, "overlay fits");

struct Args { const float* in[16]; float* out; unsigned char* ws; };

__device__ __forceinline__ float wave_sum(float v) {
#pragma unroll
    for (int o = 1; o < 64; o <<= 1) v += __shfl_xor(v, o);
    return v;
}
__device__ __forceinline__ void transpose_item(const float* __restrict__ W, int N, int k0, int n0, const float* __restrict__ gain, bf16_t* dst, int ldt, LAS float* scr, int lane) {
    f32x4 v[16];
    const int lr = lane >> 4, lc = 4 * (lane & 15);
#pragma unroll
    for (int i = 0; i < 16; ++i) v[i] = __builtin_nontemporal_load((const f32x4*)(W + (size_t)(k0 + 4 * i + lr) * N + n0 + lc));
    if (gain) {
#pragma unroll
        for (int i = 0; i < 16; ++i) v[i] = v[i] * gain[k0 + 4 * i + lr];
    }
#pragma unroll
    for (int i = 0; i < 16; ++i) { LAS float* d = scr + (4 * i + lr) * 65 + lc; d[0] = v[i][0]; d[1] = v[i][1]; d[2] = v[i][2]; d[3] = v[i][3]; }
    asm volatile("s_waitcnt lgkmcnt(0)" ::: "memory");
    const int c = lane >> 3, nl = lane & 7;
#pragma unroll
    for (int j = 0; j < 8; ++j) { const int n = nl + 8 * j; const LAS float* s = scr + (8 * c) * 65 + n;
        u32x4 o; o.x = cvt_pk_bf16(s[0 * 65], s[1 * 65]); o.y = cvt_pk_bf16(s[2 * 65], s[3 * 65]); o.z = cvt_pk_bf16(s[4 * 65], s[5 * 65]); o.w = cvt_pk_bf16(s[6 * 65], s[7 * 65]);
        *(u32x4*)(dst + (size_t)n * ldt + 8 * c) = o; }
    asm volatile("s_waitcnt lgkmcnt(0)" ::: "memory");
}
__device__ __forceinline__ int dest_row(int mode, int n) {
    if (mode == 1) return (n >> 7) * 256 + (n & 127);
    if (mode == 2) return (n >> 7) * 256 + 128 + (n & 127);
    if (mode == 3) return n < 2048 ? n : (n < 3072 ? n + 1024 : n - 1024);
    return n;
}
__device__ __forceinline__ void transpose_mat(const float* W, int K, int N, const float* gain, bf16_t* WT, int mode, int item, LAS float* scr, int lane) {
    const int nblk = N / 64, kb = item / nblk, nb = item % nblk;
    transpose_item(W, N, 64 * kb, 64 * nb, gain, WT + (size_t)dest_row(mode, 64 * nb) * K + 64 * kb, K, scr, lane);
}

template <int WIN> __device__ __forceinline__ void pooled_tile(const bf16_t* __restrict__ UB, bf16_t* __restrict__ PL, int g, int pm, int tidp) {
#pragma unroll 1
    for (int pass = 0; pass < 2; ++pass) {
        const int chunk = tidp & 31, seg = (tidp >> 5) + 16 * pass;
        const int r0 = pm * 256 + seg * 8, sq0 = r0 & (SEQ - 1);
        const bf16_t* up = UB + (size_t)r0 * AW + g * 256 + chunk * 8;
        u32x4 rows[7 + WIN];
#pragma unroll
        for (int k = 0; k < 7 + WIN; ++k) { const int rel = k - (WIN - 1);
            rows[k] = (sq0 + rel >= 0) ? *(const u32x4*)(up + (long)rel * AW) : (u32x4){0u, 0u, 0u, 0u}; }
        float sm[8];
#pragma unroll
        for (int j = 0; j < 8; ++j) sm[j] = 0.f;
#pragma unroll
        for (int k = 0; k < WIN; ++k)
#pragma unroll
            for (int j = 0; j < 4; ++j) { sm[2 * j] += __builtin_bit_cast(float, rows[k][j] << 16); sm[2 * j + 1] += __builtin_bit_cast(float, rows[k][j] & 0xffff0000u); }
#pragma unroll
        for (int i = 0; i < 8; ++i) {
            if (i > 0) {
#pragma unroll
                for (int j = 0; j < 4; ++j) {
                    sm[2 * j] += __builtin_bit_cast(float, rows[WIN - 1 + i][j] << 16) - __builtin_bit_cast(float, rows[i - 1][j] << 16);
                    sm[2 * j + 1] += __builtin_bit_cast(float, rows[WIN - 1 + i][j] & 0xffff0000u) - __builtin_bit_cast(float, rows[i - 1][j] & 0xffff0000u); }
            }
            const int c = sq0 + i + 1; const float ic = 1.0f / (float)(c < WIN ? c : WIN);
            const u32x4 self = rows[WIN - 1 + i]; u32x4 o;
#pragma unroll
            for (int j = 0; j < 4; ++j) o[j] = cvt_pk_bf16(sm[2 * j] * ic - __builtin_bit_cast(float, self[j] << 16), sm[2 * j + 1] * ic - __builtin_bit_cast(float, self[j] & 0xffff0000u));
            *(u32x4*)(PL + ((size_t)g * M + r0 + i) * 256 + chunk * 8) = o;
        }
    }
}

__global__ void __launch_bounds__(NWAVES * 64, 2) fwd_kernel(Args args) {
    extern __shared__ __attribute__((aligned(16))) unsigned char lds_raw[];
    LAS unsigned char* lds = (LAS unsigned char*)lds_raw;
    cg::grid_group grid = cg::this_grid();
    const int tid = threadIdx.x, lane = tid & 63; const int wave = __builtin_amdgcn_readfirstlane(tid >> 6);
    if (tid < 16) ((LAS unsigned*)(lds + LDS_MISC))[tid] = 0u;
    __syncthreads();
    const XcdBarrier xbar = xcd_barrier_post((unsigned*)(args.ws + WS_CTL), (volatile LAS unsigned*)(lds + LDS_MISC));
    if (args.ws == nullptr) grid.sync();
    const int G = gridDim.x, bx = blockIdx.x;
    const int vcu = (G % 8 == 0) ? (bx % 8) * (G / 8) + bx / 8 : bx;
    unsigned char* ws = args.ws;
    const float* x = args.in[0]; const int* pos = (const int*)args.in[1];
    const float *g_ffn1 = args.in[2], *w1g = args.in[3], *w1u = args.in[4], *w1d = args.in[5], *g_mix = args.in[6], *w_in = args.in[7], *pool_w = args.in[8], *pool_scale = args.in[9],
                *w_out = args.in[10], *g_ffn2 = args.in[11], *w2g = args.in[12], *w2u = args.in[13], *w2d = args.in[14], *g_fin = args.in[15];
    float* out = args.out;
    float* ss0 = (float*)(ws + WS_SS); float* ss1 = ss0 + M; float* ss2 = ss1 + M; float* ss3 = ss2 + M;
    float* kmean = (float*)(ws + WS_KMEAN);
    bf16_t *WGU1 = (bf16_t*)(ws + WS_WGU1), *WD1 = (bf16_t*)(ws + WS_WD1), *WIN = (bf16_t*)(ws + WS_WIN), *WPOOL = (bf16_t*)(ws + WS_WPOOL), *WOUT = (bf16_t*)(ws + WS_WOUT),
           *WGU2 = (bf16_t*)(ws + WS_WGU2), *WD2 = (bf16_t*)(ws + WS_WD2);
    bf16_t *XB = (bf16_t*)(ws + WS_XB), *ACT = (bf16_t*)(ws + WS_ACT), *QB = (bf16_t*)(ws + WS_Q), *KB = (bf16_t*)(ws + WS_K), *VTB = (bf16_t*)(ws + WS_VT), *UB = (bf16_t*)(ws + WS_U),
           *PL = (bf16_t*)(ws + WS_PL), *MIX = (bf16_t*)(ws + WS_MIX);
    const int gw = vcu * NWAVES + wave, NGW = G * NWAVES;
    const int gt = bx * (NWAVES * 64) + tid, NGT = G * NWAVES * 64;

    for (int rep = 0; rep < REP_P0; ++rep) {
        for (int i = gt; i < 3 * M; i += NGT) ss1[i] = 0.f;
        for (int i = gt; i < 4 * NH * 16 * HD; i += NGT) kmean[i] = 0.f;
        LAS float* scr = (LAS float*)(lds + wave * 16640);
        constexpr int I_GU = (D / 64) * (FF / 64), I_DN = (FF / 64) * (D / 64), I_IN = (D / 64) * (4096 / 64), I_PW = (256 / 64) * (256 / 64), I_OUT = (D / 64) * (D / 64);
        constexpr int NITEMS = 4 * I_GU + 2 * I_DN + I_IN + 4 * I_PW + I_OUT;
        for (int it = gw; it < NITEMS; it += NGW) {
            int r = it;
            if (r < I_GU) { transpose_mat(w1g, D, FF, g_ffn1, WGU1, 1, r, scr, lane); continue; } r -= I_GU;
            if (r < I_GU) { transpose_mat(w1u, D, FF, g_ffn1, WGU1, 2, r, scr, lane); continue; } r -= I_GU;
            if (r < I_DN) { transpose_mat(w1d, FF, D, nullptr, WD1, 0, r, scr, lane); continue; } r -= I_DN;
            if (r < I_IN) { transpose_mat(w_in, D, 4096, g_mix, WIN, 3, r, scr, lane); continue; } r -= I_IN;
            if (r < 4 * I_PW) { const int g = r / I_PW; transpose_mat(pool_w + (size_t)g * 65536, 256, 256, nullptr, WPOOL + (size_t)g * 65536, 0, r % I_PW, scr, lane); continue; } r -= 4 * I_PW;
            if (r < I_OUT) { transpose_mat(w_out, D, D, nullptr, WOUT, 0, r, scr, lane); continue; } r -= I_OUT;
            if (r < I_GU) { transpose_mat(w2g, D, FF, g_ffn2, WGU2, 1, r, scr, lane); continue; } r -= I_GU;
            if (r < I_GU) { transpose_mat(w2u, D, FF, g_ffn2, WGU2, 2, r, scr, lane); continue; } r -= I_GU;
            transpose_mat(w2d, FF, D, nullptr, WD2, 0, r, scr, lane);
        }
        for (int m = gw; m < M; m += NGW) {
            const f32x4* xr = (const f32x4*)(x + (size_t)m * D) + lane; float s = 0.f; f32x4 v[8];
#pragma unroll
            for (int j = 0; j < 8; ++j) { v[j] = __builtin_nontemporal_load(xr + 64 * j); s += (v[j][0] * v[j][0] + v[j][1] * v[j][1]) + (v[j][2] * v[j][2] + v[j][3] * v[j][3]); }
            s = wave_sum(s);
            u32x2* o8 = (u32x2*)(XB + (size_t)m * D) + lane;
#pragma unroll
            for (int j = 0; j < 8; ++j) { u32x2 w; w.x = cvt_pk_bf16(v[j][0], v[j][1]); w.y = cvt_pk_bf16(v[j][2], v[j][3]); o8[64 * j] = w; }
            if (lane == 0) ss0[m] = s;
        }
    }
    xcd_barrier(xbar);
    for (int rep = 0; rep < REP_P1; ++rep) { pg8::Gemm g{XB, WGU1, M, 2 * FF, D}; pg8::StaticOrder S; S.init(M, 2 * FF, G, bx); pg8::EpiSwiglu E{ACT, ss0};
      pg8::gemm_phase<pg8::EpiSwiglu, pg8::StaticOrder, true, true>(lds, g, S, E); }
    xcd_barrier(xbar);
    { pg8::Gemm g{ACT, WD1, M, D, FF}; pg8::StaticOrder S; S.init(M, D, G, bx); pg8::EpiResid<true> E{nullptr, XB, XB, ss1, 0.5f};
      pg8::gemm_phase<pg8::EpiResid<true>, pg8::StaticOrder, true, true>(lds, g, S, E); }
    xcd_barrier(xbar);
    { pg8::Gemm g{XB, WIN, M, NQKU, D}; pg8::StaticOrder S; S.init(M, NQKU, G, bx); pg8::EpiInProj E{QB, ss1, pos, kmean};
      pg8::gemm_phase<pg8::EpiInProj, pg8::StaticOrder, true, true>(lds, g, S, E); }
    { pg8::Gemm g{WIN + (size_t)NQKU * D, XB, AW, M, D}; pg8::StaticOrder S; S.init(AW, M, G, bx); pg8::EpiVT E{VTB, ss1};
      pg8::gemm_phase<pg8::EpiVT, pg8::StaticOrder, true, true>(lds, g, S, E); }
    xcd_barrier(xbar);
    {
        for (int rep = 0; rep < REP_ATT; ++rep)
        for (int pr = vcu; pr < 256; pr += G) {
            const int bh = pr >> 3, s = pr & 7;
#pragma nounroll
            for (int k2 = 0; k2 < 2; ++k2) att::attn_unit(bh >> 3, bh & 7, k2 ? s : 15 - s, QB, KB, VTB, kmean, MIX, lds);
        }
        int tidp = threadIdx.x; asm volatile("" : "+v"(tidp));
        for (int L = bx; L < 256; L += G) {
            const int g = L >> 6, pm = L & 63;
            if (g == 0) pooled_tile<2>(UB, PL, g, pm, tidp); else if (g == 1) pooled_tile<4>(UB, PL, g, pm, tidp); else if (g == 2) pooled_tile<8>(UB, PL, g, pm, tidp); else pooled_tile<16>(UB, PL, g, pm, tidp);
            asm volatile("s_waitcnt vmcnt(0)" ::: "memory");
            __syncthreads();
            int Kp = 256; asm volatile("" : "+s"(Kp));
            pg8::Gemm gm{PL, WPOOL, 4 * M, 1024, Kp}; pg8::OneUnit S; S.u0.pm = g * 64 + pm; S.u0.pn = g; pg8::EpiPool E{MIX, pool_scale};
            pg8::gemm_phase<pg8::EpiPool, pg8::OneUnit, false, true>(lds, gm, S, E);
        }
    }
    xcd_barrier(xbar);
    { pg8::Gemm g{MIX, WOUT, M, D, D}; pg8::StaticOrder S; S.init(M, D, G, bx); pg8::EpiResid<true> E{nullptr, XB, XB, ss2, 1.0f};
      pg8::gemm_phase<pg8::EpiResid<true>, pg8::StaticOrder, true, true>(lds, g, S, E); }
    xcd_barrier(xbar);
    { pg8::Gemm g{XB, WGU2, M, 2 * FF, D}; pg8::StaticOrder S; S.init(M, 2 * FF, G, bx); pg8::EpiSwiglu E{ACT, ss2};
      pg8::gemm_phase<pg8::EpiSwiglu, pg8::StaticOrder, true, true>(lds, g, S, E); }
    xcd_barrier(xbar);
    { pg8::Gemm g{ACT, WD2, M, D, FF}; pg8::StaticOrder S; S.init(M, D, G, bx); pg8::EpiResid<true> E{nullptr, XB, XB, ss3, 0.5f};
      pg8::gemm_phase<pg8::EpiResid<true>, pg8::StaticOrder, true, true>(lds, g, S, E); }
    xcd_barrier(xbar);
    int lane8 = threadIdx.x & 63; asm volatile("" : "+v"(lane8));
    for (int m = gw; m < M; m += NGW) {
        const u32x4* xr = (const u32x4*)(XB + (size_t)m * D) + lane8; f32x4* orow = (f32x4*)(out + (size_t)m * D) + 2 * lane8; const f32x4* gr = (const f32x4*)g_fin + 2 * lane8;
        const float rs = __builtin_amdgcn_rsqf(ss3[m] * (1.0f / D) + EPS);
#pragma unroll
        for (int j = 0; j < 4; ++j) { const u32x4 h = __builtin_nontemporal_load(xr + 64 * j); const f32x4 g0 = gr[128 * j], g1 = gr[128 * j + 1];
            const f32x4 v0 = (f32x4){__builtin_bit_cast(float, h[0] << 16), __builtin_bit_cast(float, h[0] & 0xffff0000u), __builtin_bit_cast(float, h[1] << 16), __builtin_bit_cast(float, h[1] & 0xffff0000u)};
            const f32x4 v1 = (f32x4){__builtin_bit_cast(float, h[2] << 16), __builtin_bit_cast(float, h[2] & 0xffff0000u), __builtin_bit_cast(float, h[3] << 16), __builtin_bit_cast(float, h[3] & 0xffff0000u)};
            __builtin_nontemporal_store(v0 * rs * g0, orow + 128 * j); __builtin_nontemporal_store(v1 * rs * g1, orow + 128 * j + 1); }
    }
}

extern "C" void kernel_launch(void* const* d_in, const int* in_sizes, int n_in, void* d_out, int out_size, void* d_ws, size_t ws_size, hipStream_t stream) {
    static int grid = 0;
    if (grid == 0) {
        if (n_in != 16 || out_size != M * D || ws_size < WS_END) { fprintf(stderr, "kernel_launch: unexpected problem (n_in %d out %d ws %zu need %zu)\n", n_in, out_size, ws_size, (size_t)WS_END); grid = -1; return; }
        int dev = 0, cus = 0, per_cu = 0;
        (void)hipGetDevice(&dev);
        (void)hipDeviceGetAttribute(&cus, hipDeviceAttributeMultiprocessorCount, dev);
        (void)hipFuncSetAttribute((const void*)fwd_kernel, hipFuncAttributeMaxDynamicSharedMemorySize, LDS_BYTES);
        (void)hipOccupancyMaxActiveBlocksPerMultiprocessor(&per_cu, (const void*)fwd_kernel, NWAVES * 64, LDS_BYTES);
        if (per_cu < 1) { fprintf(stderr, "kernel_launch: occupancy query says %d blocks per CU\n", per_cu); per_cu = 1; }
        grid = cus;
    }
    if (grid < 0) return;
    if (hipMemsetAsync((char*)d_ws + WS_CTL, 0, CTL_BYTES, stream) != hipSuccess) { fprintf(stderr, "kernel_launch: memset of barrier words failed\n"); return; }
    Args a{};
    for (int i = 0; i < 16; ++i) a.in[i] = (const float*)d_in[i];
    a.out = (float*)d_out; a.ws = (unsigned char*)d_ws;
    void* kargs[] = {&a};
    hipError_t e = hipLaunchCooperativeKernel((const void*)fwd_kernel, dim3(grid), dim3(NWAVES * 64), kargs, LDS_BYTES, stream);
    if (e != hipSuccess) fprintf(stderr, "cooperative launch failed: %s (grid %d)\n", hipGetErrorString(e), grid);
}
```
